# Optimizing an MI355X kernel written in HIP

```python
import math
import jax, jax.numpy as jnp
from jax import lax
import numpy as np

D_MODEL = 1024
BATCH = 8
SEQ = 4096
DEPTH = 1

ATTN_HEADS = 4
HEAD_DIM = 64
ATTN_WIDTH = ATTN_HEADS * 2 * HEAD_DIM
CONV_WIDTH = D_MODEL - ATTN_WIDTH
CONV_GROUPS = 8
CONV_K = 3
D_FF = 2816
ROPE_THETA = 10000.0
Q_BLOCK = 128
NORM_EPS = 1e-6
SUBLN_EPS = 1e-5
N_MOD = 9
IN_COLS = 3 * ATTN_WIDTH + 3 * CONV_WIDTH

kernel_name = "hymba_diffattn_shortconv_macaron_adaln"


def rmsnorm(x, g, eps=NORM_EPS):
    x32 = x.astype(jnp.float32)
    y = x32 * lax.rsqrt(jnp.mean(x32 * x32, axis=-1, keepdims=True) + eps)
    return (y * g.astype(jnp.float32)).astype(x.dtype)


def modulate(h, shift, scale):
    return h * (1.0 + scale[:, None, :]) + shift[:, None, :]


def swiglu(h, w1, w3, w2):
    return (jax.nn.silu(h @ w1) * (h @ w3)) @ w2


def rope_tables(seq, dim, dtype):
    inv = 1.0 / (ROPE_THETA ** (jnp.arange(0, dim, 2, dtype=jnp.float32) / dim))
    ang = jnp.arange(seq, dtype=jnp.float32)[:, None] * inv[None, :]
    ang = jnp.concatenate([ang, ang], axis=-1)
    return jnp.cos(ang).astype(dtype), jnp.sin(ang).astype(dtype)


def apply_rope(t, cos, sin):
    half = t.shape[-1] // 2
    t1, t2 = t[..., :half], t[..., half:]
    rot = jnp.concatenate([-t2, t1], axis=-1)
    return t * cos[None, :, None, None, :] + rot * sin[None, :, None, None, :]


def diff_attention(q, k, v, lam):
    b, s, h, _, dh = q.shape
    nb = s // Q_BLOCK
    scale = 1.0 / math.sqrt(dh)
    qb = q.reshape(b, nb, Q_BLOCK, h, 2, dh).transpose(1, 0, 2, 3, 4, 5)
    kpos = jnp.arange(s)
    lam32 = lam.astype(jnp.float32)

    def block(args):
        qblk, i = args
        sc = jnp.einsum('bqhcd,bkhcd->bhcqk', qblk, k,
                        preferred_element_type=jnp.float32) * scale
        qpos = i * Q_BLOCK + jnp.arange(Q_BLOCK)
        mask = kpos[None, :] <= qpos[:, None]
        sc = jnp.where(mask[None, None, None], sc, -jnp.inf)
        p = jax.nn.softmax(sc, axis=-1)
        p = p[:, :, 0] - lam32 * p[:, :, 1]
        return jnp.einsum('bhqk,bkhe->bqhe', p.astype(v.dtype), v)

    out = lax.map(block, (qb, jnp.arange(nb)))
    return out.transpose(1, 0, 2, 3, 4).reshape(b, s, h, v.shape[-1])


def causal_short_conv(u, w):
    ch = u.shape[-1]
    return lax.conv_general_dilated(
        u, w[:, None, :].astype(u.dtype), window_strides=(1,),
        padding=[(CONV_K - 1, 0)], dimension_numbers=('NWC', 'WIO', 'NWC'),
        feature_group_count=ch)


def hybrid_mixer(h, w_in, lq1, lk1, lq2, lk2, subln_g, conv_w, conv_norm_g, w_out,
                 cos, sin, lambda_init):
    b, s, _ = h.shape
    z = h @ w_in
    cuts = [ATTN_WIDTH, 2 * ATTN_WIDTH, 3 * ATTN_WIDTH,
            3 * ATTN_WIDTH + CONV_WIDTH, 3 * ATTN_WIDTH + 2 * CONV_WIDTH]
    q, k, v, gate_b, gate_c, u = jnp.split(z, cuts, axis=-1)
    q = apply_rope(q.reshape(b, s, ATTN_HEADS, 2, HEAD_DIM), cos, sin)
    k = apply_rope(k.reshape(b, s, ATTN_HEADS, 2, HEAD_DIM), cos, sin)
    v = v.reshape(b, s, ATTN_HEADS, 2 * HEAD_DIM)
    f32 = jnp.float32
    lam = (jnp.exp(jnp.sum(lq1.astype(f32) * lk1.astype(f32)))
           - jnp.exp(jnp.sum(lq2.astype(f32) * lk2.astype(f32))) + lambda_init)
    o = diff_attention(q, k, v, lam)
    o = rmsnorm(o, subln_g, SUBLN_EPS) * (1.0 - lambda_init)
    attn_out = o.reshape(b, s, ATTN_WIDTH)
    y = gate_b * causal_short_conv(gate_c * u, conv_w)
    gsz = CONV_WIDTH // CONV_GROUPS
    y = rmsnorm(y.reshape(b, s, CONV_GROUPS, gsz),
                conv_norm_g.reshape(CONV_GROUPS, gsz)).reshape(b, s, CONV_WIDTH)
    return jnp.concatenate([attn_out, y], axis=-1) @ w_out


def setup_inputs(seed: int = 0) -> dict:
    key = jax.random.key(seed)
    ks = iter(jax.random.split(key, 32))
    nrm = lambda shape, s: jax.random.normal(next(ks), shape, jnp.float32) * s
    gain = lambda shape: 1.0 + nrm(shape, 0.02)
    D = D_MODEL
    return {
        "x": nrm((BATCH, SEQ, D), 1.0),
        "c": nrm((BATCH, D), 1.0),
        "w_ada": nrm((DEPTH, D, N_MOD * D), D ** -0.5),
        "b_ada": nrm((DEPTH, N_MOD * D), 0.02),
        "w_ada_final": nrm((D, 2 * D), D ** -0.5),
        "b_ada_final": nrm((2 * D,), 0.02),
        "g_ffn1": gain((DEPTH, D)),
        "g_mix": gain((DEPTH, D)),
        "g_ffn2": gain((DEPTH, D)),
        "g_final": gain((D,)),
        "ffn1_w1": nrm((DEPTH, D, D_FF), D ** -0.5),
        "ffn1_w3": nrm((DEPTH, D, D_FF), D ** -0.5),
        "ffn1_w2": nrm((DEPTH, D_FF, D), D_FF ** -0.5),
        "ffn2_w1": nrm((DEPTH, D, D_FF), D ** -0.5),
        "ffn2_w3": nrm((DEPTH, D, D_FF), D ** -0.5),
        "ffn2_w2": nrm((DEPTH, D_FF, D), D_FF ** -0.5),
        "w_in": nrm((DEPTH, D, IN_COLS), D ** -0.5),
        "lambda_q1": nrm((DEPTH, HEAD_DIM), 0.1),
        "lambda_k1": nrm((DEPTH, HEAD_DIM), 0.1),
        "lambda_q2": nrm((DEPTH, HEAD_DIM), 0.1),
        "lambda_k2": nrm((DEPTH, HEAD_DIM), 0.1),
        "subln_g": gain((DEPTH, 2 * HEAD_DIM)),
        "conv_w": nrm((DEPTH, CONV_K, CONV_WIDTH), CONV_K ** -0.5),
        "conv_norm_g": gain((DEPTH, CONV_WIDTH)),
        "w_out": nrm((DEPTH, D, D), D ** -0.5),
    }


def reference(x, c, w_ada, b_ada, w_ada_final, b_ada_final, g_ffn1, g_mix, g_ffn2, g_final,
              ffn1_w1, ffn1_w3, ffn1_w2, ffn2_w1, ffn2_w3, ffn2_w2, w_in,
              lambda_q1, lambda_k1, lambda_q2, lambda_k2, subln_g, conv_w, conv_norm_g, w_out):
    s = x.shape[1]
    cos, sin = rope_tables(s, HEAD_DIM, x.dtype)
    c_act = jax.nn.silu(c)
    for l in range(DEPTH):
        lambda_init = 0.8 - 0.6 * math.exp(-0.3 * l)
        mod = c_act @ w_ada[l] + b_ada[l]
        sh1, sc1, gt1, sh2, sc2, gt2, sh3, sc3, gt3 = jnp.split(mod, N_MOD, axis=-1)
        h = modulate(rmsnorm(x, g_ffn1[l]), sh1, sc1)
        x = x + 0.5 * gt1[:, None, :] * swiglu(h, ffn1_w1[l], ffn1_w3[l], ffn1_w2[l])
        h = modulate(rmsnorm(x, g_mix[l]), sh2, sc2)
        x = x + gt2[:, None, :] * hybrid_mixer(
            h, w_in[l], lambda_q1[l], lambda_k1[l], lambda_q2[l], lambda_k2[l],
            subln_g[l], conv_w[l], conv_norm_g[l], w_out[l], cos, sin, lambda_init)
        h = modulate(rmsnorm(x, g_ffn2[l]), sh3, sc3)
        x = x + 0.5 * gt3[:, None, :] * swiglu(h, ffn2_w1[l], ffn2_w3[l], ffn2_w2[l])
    modf = c_act @ w_ada_final + b_ada_final
    shf, scf = jnp.split(modf, 2, axis=-1)
    return modulate(rmsnorm(x, g_final), shf, scf)
```

```cpp
#include <hip/hip_runtime.h>
#include <cstdio>
#include <cstdint>
#include <cmath>

constexpr int BATCH = 8, SEQ = 4096, D = 1024, M = BATCH * SEQ, FF = 2816, NIN = 3072, AW = 512, CWID = 512;
constexpr int NMOD = 9 * D, NMODF = 2 * D;
constexpr float NORM_EPS = 1e-6f, SUBLN_EPS = 1e-5f, LAMBDA_INIT = 0.2f;
constexpr float QSCALE = 0.125f * 1.4426950408889634f;

constexpr size_t MiB = 1u << 20;
constexpr size_t WS_CTL = 0, CTL_ZERO_BYTES = 1 * MiB;
constexpr size_t WS_W13A = 1 * MiB, WS_W2A = 12 * MiB, WS_W13B = 18 * MiB, WS_W2B = 29 * MiB, WS_WIN = 35 * MiB, WS_WOUT = 41 * MiB;
constexpr size_t WS_ROPE = 43 * MiB;
constexpr size_t WS_MOD = 44 * MiB;
constexpr size_t WS_MODF = WS_MOD + (size_t)BATCH * NMOD * 4, WS_LAM = WS_MODF + (size_t)BATCH * NMODF * 4;
constexpr size_t WS_H = 48 * MiB;
constexpr size_t WS_G = 112 * MiB;
constexpr size_t WS_Q = 112 * MiB, WS_K = 144 * MiB, WS_V = 176 * MiB, WS_B = 208 * MiB, WS_C = 240 * MiB, WS_U = 272 * MiB;
constexpr size_t WS_AO = 304 * MiB;
constexpr size_t WS_END = 368 * MiB;

typedef unsigned short bf16;
__device__ __forceinline__ float bf2f(unsigned v) { return __uint_as_float(v << 16); }
__device__ __forceinline__ unsigned f2bf(float f) { unsigned u = __float_as_uint(f); return (u + 0x7fffu + ((u >> 16) & 1u)) >> 16; }
__device__ __forceinline__ unsigned pk2(float lo, float hi) { return f2bf(lo) | (f2bf(hi) << 16); }
typedef float f32x4 __attribute__((ext_vector_type(4)));
typedef unsigned v4u __attribute__((ext_vector_type(4)));
typedef unsigned v2u __attribute__((ext_vector_type(2)));

__device__ __forceinline__ float wave_sum(float v) {
#pragma unroll
    for (int o = 1; o < 64; o <<= 1) v += __shfl_xor(v, o);
    return v;
}
__device__ __forceinline__ float silu_f(float v) { return v / (1.0f + __expf(-v)); }

template <bool TOBF>
__device__ __forceinline__ void norm_row(const float* xrow, void* orow, const f32x4 (&gm)[4], const f32x4 (&sh)[4], int lane) {
    const f32x4* xr = (const f32x4*)xrow + lane;
    f32x4 v[4]; float s = 0.f;
#pragma unroll
    for (int j = 0; j < 4; ++j) { v[j] = xr[64 * j]; s += (v[j].x * v[j].x + v[j].y * v[j].y) + (v[j].z * v[j].z + v[j].w * v[j].w); }
    const float r = 1.0f / sqrtf(wave_sum(s) * (1.f / D) + NORM_EPS);
#pragma unroll
    for (int j = 0; j < 4; ++j) {
        const f32x4 o = v[j] * r * gm[j] + sh[j];
        if (TOBF) { v2u w; w.x = pk2(o.x, o.y); w.y = pk2(o.z, o.w); ((v2u*)orow)[lane + 64 * j] = w; }
        else ((f32x4*)orow)[lane + 64 * j] = o;
    }
}
template <bool TOBF>
__device__ __forceinline__ void norm_rows(const float* xs, void* out, const float* g, const float* shv, const float* scv, int r0, int nrows, int lane) {
    f32x4 gm[4], sh[4];
#pragma unroll
    for (int j = 0; j < 4; ++j) { const f32x4 gg = ((const f32x4*)g)[lane + 64 * j], sc = ((const f32x4*)scv)[lane + 64 * j]; gm[j] = gg * (sc + 1.0f); sh[j] = ((const f32x4*)shv)[lane + 64 * j]; }
    for (int r = r0; r < r0 + nrows; ++r) {
        if (TOBF) norm_row<true>(xs + (size_t)r * D, (bf16*)out + (size_t)r * D, gm, sh, lane);
        else norm_row<false>(xs + (size_t)r * D, (float*)out + (size_t)r * D, gm, sh, lane);
    }
}

__device__ __forceinline__ void unpack8(const v4u w, float (&f)[8]) {
    f[0] = bf2f(w.x & 0xffffu); f[1] = bf2f(w.x >> 16); f[2] = bf2f(w.y & 0xffffu); f[3] = bf2f(w.y >> 16);
    f[4] = bf2f(w.z & 0xffffu); f[5] = bf2f(w.z >> 16); f[6] = bf2f(w.w & 0xffffu); f[7] = bf2f(w.w >> 16);
}
__device__ __forceinline__ v4u pack8(const float (&f)[8]) { v4u w; w.x = pk2(f[0], f[1]); w.y = pk2(f[2], f[3]); w.z = pk2(f[4], f[5]); w.w = pk2(f[6], f[7]); return w; }
__device__ __forceinline__ void mix_rows(const bf16* AO, const bf16* Bb, const bf16* Cb, const bf16* Ub, bf16* MIX, const float* subln_g, const float* conv_w, const float* conv_g,
                                         float lam, int r0, int nrows, int lane) {
    float sg[8], w0[8], w1[8], w2[8], cg[8];
#pragma unroll
    for (int i = 0; i < 8; ++i) { sg[i] = subln_g[8 * (lane & 15) + i] * (1.0f - LAMBDA_INIT); w0[i] = conv_w[8 * lane + i]; w1[i] = conv_w[CWID + 8 * lane + i]; w2[i] = conv_w[2 * CWID + 8 * lane + i]; cg[i] = conv_g[8 * lane + i]; }
    float cu1[8], cu2[8];
    {
        const int t0 = r0 & (SEQ - 1);
#pragma unroll
        for (int i = 0; i < 8; ++i) { cu1[i] = 0.f; cu2[i] = 0.f; }
        if (t0 >= 1) { float c[8], u[8]; unpack8(((const v4u*)(Cb + (size_t)(r0 - 1) * CWID))[lane], c); unpack8(((const v4u*)(Ub + (size_t)(r0 - 1) * CWID))[lane], u);
#pragma unroll
            for (int i = 0; i < 8; ++i) cu1[i] = c[i] * u[i]; }
        if (t0 >= 2) { float c[8], u[8]; unpack8(((const v4u*)(Cb + (size_t)(r0 - 2) * CWID))[lane], c); unpack8(((const v4u*)(Ub + (size_t)(r0 - 2) * CWID))[lane], u);
#pragma unroll
            for (int i = 0; i < 8; ++i) cu2[i] = c[i] * u[i]; }
    }
    for (int r = r0; r < r0 + nrows; ++r) {
        float a0[8], a1[8], o[8]; unpack8(((const v4u*)(AO + (size_t)r * D))[lane], a0); unpack8(((const v4u*)(AO + (size_t)r * D + AW))[lane], a1);
        float ss = 0.f;
#pragma unroll
        for (int i = 0; i < 8; ++i) { o[i] = a0[i] - lam * a1[i]; ss += o[i] * o[i]; }
        ss += __shfl_xor(ss, 1); ss += __shfl_xor(ss, 2); ss += __shfl_xor(ss, 4); ss += __shfl_xor(ss, 8);
        const float ra = 1.0f / sqrtf(ss * (1.f / 128.f) + SUBLN_EPS);
#pragma unroll
        for (int i = 0; i < 8; ++i) o[i] = o[i] * ra * sg[i];
        ((v4u*)(MIX + (size_t)r * D))[lane] = pack8(o);
        float c[8], u[8], bb[8], y[8]; unpack8(((const v4u*)(Cb + (size_t)r * CWID))[lane], c); unpack8(((const v4u*)(Ub + (size_t)r * CWID))[lane], u); unpack8(((const v4u*)(Bb + (size_t)r * CWID))[lane], bb);
        float s2 = 0.f;
#pragma unroll
        for (int i = 0; i < 8; ++i) { const float cu0 = c[i] * u[i]; y[i] = bb[i] * (w0[i] * cu2[i] + w1[i] * cu1[i] + w2[i] * cu0); cu2[i] = cu1[i]; cu1[i] = cu0; s2 += y[i] * y[i]; }
        s2 += __shfl_xor(s2, 1); s2 += __shfl_xor(s2, 2); s2 += __shfl_xor(s2, 4);
        const float rc = 1.0f / sqrtf(s2 * (1.f / 64.f) + NORM_EPS);
#pragma unroll
        for (int i = 0; i < 8; ++i) y[i] = y[i] * rc * cg[i];
        ((v4u*)(MIX + (size_t)r * D + AW))[lane] = pack8(y);
    }
}
__device__ __forceinline__ float lam_value(const float* lq1, const float* lk1, const float* lq2, const float* lk2) {
    float s1 = 0.f, s2 = 0.f;
    for (int i = 0; i < 64; ++i) { s1 += lq1[i] * lk1[i]; s2 += lq2[i] * lk2[i]; }
    return expf(s1) - expf(s2) + LAMBDA_INIT;
}
namespace nv {
__global__ void __launch_bounds__(256) k_ada(const float* __restrict__ c, const float* __restrict__ w_ada, const float* __restrict__ b_ada, const float* __restrict__ w_adaf, const float* __restrict__ b_adaf,
                                             float* mod, float* modf, const float* lq1, const float* lk1, const float* lq2, const float* lk2, float* lam) {
    const int gid = blockIdx.x * 256 + threadIdx.x;
    if (gid == 0) *lam = lam_value(lq1, lk1, lq2, lk2);
    if (gid >= BATCH * (NMOD + NMODF)) return;
    const int b = gid / (NMOD + NMODF); int j = gid % (NMOD + NMODF);
    const float* W; int ld; float bias; float* dst;
    if (j < NMOD) { W = w_ada + j; ld = NMOD; bias = b_ada[j]; dst = mod + (size_t)b * NMOD + j; }
    else { j -= NMOD; W = w_adaf + j; ld = NMODF; bias = b_adaf[j]; dst = modf + (size_t)b * NMODF + j; }
    float acc = 0.f;
    for (int k = 0; k < D; ++k) { const float cv = c[b * D + k]; acc += (cv / (1.0f + expf(-cv))) * W[(size_t)k * ld]; }
    *dst = acc + bias;
}
template <bool TOBF>
__global__ void __launch_bounds__(256) k_norm(const float* xs, void* out, const float* g, const float* shbase, const float* scbase, int ldmod) {
    const int lane = threadIdx.x & 63, gw = blockIdx.x * 4 + (threadIdx.x >> 6), r0 = gw * 16, b = r0 / SEQ;
    norm_rows<TOBF>(xs, out, g, shbase + (size_t)b * ldmod, scbase + (size_t)b * ldmod, r0, 16, lane);
}
__global__ void __launch_bounds__(256) k_mix(const bf16* AO, const bf16* Bb, const bf16* Cb, const bf16* Ub, bf16* MIX, const float* subln_g, const float* conv_w, const float* conv_g, const float* lam) {
    const int lane = threadIdx.x & 63, gw = blockIdx.x * 4 + (threadIdx.x >> 6), r0 = gw * 16;
    mix_rows(AO, Bb, Cb, Ub, MIX, subln_g, conv_w, conv_g, *lam, r0, 16, lane);
}

template <int NB>
__device__ __forceinline__ void gemm_tile(const bf16* A, int lda, const float* W0, const float* W1, int ldw, int K, int row0, int col0, float (&acc)[NB][4][4], float* As, float* Bs) {
    const int tid = threadIdx.x, ty = tid >> 4, tx = tid & 15;
#pragma unroll
    for (int n = 0; n < NB; ++n)
#pragma unroll
        for (int i = 0; i < 4; ++i)
#pragma unroll
            for (int j = 0; j < 4; ++j) acc[n][i][j] = 0.f;
    for (int k0 = 0; k0 < K; k0 += 16) {
        __syncthreads();
        { const int r = tid >> 2, kk = (tid & 3) * 4; const v2u w = *(const v2u*)(A + (size_t)(row0 + r) * lda + k0 + kk);
          As[(kk + 0) * 68 + r] = bf2f(w.x & 0xffffu); As[(kk + 1) * 68 + r] = bf2f(w.x >> 16); As[(kk + 2) * 68 + r] = bf2f(w.y & 0xffffu); As[(kk + 3) * 68 + r] = bf2f(w.y >> 16); }
        { const int k = tid >> 4, cc = (tid & 15) * 4;
          *(f32x4*)(Bs + k * 64 + cc) = *(const f32x4*)(W0 + (size_t)(k0 + k) * ldw + col0 + cc);
          if (NB == 2) *(f32x4*)(Bs + 1024 + k * 64 + cc) = *(const f32x4*)(W1 + (size_t)(k0 + k) * ldw + col0 + cc); }
        __syncthreads();
#pragma unroll
        for (int k = 0; k < 16; ++k) {
            const f32x4 a = *(const f32x4*)(As + k * 68 + ty * 4);
#pragma unroll
            for (int n = 0; n < NB; ++n) {
                float b[4];
#pragma unroll
                for (int j = 0; j < 4; ++j) b[j] = Bs[n * 1024 + k * 64 + tx + 16 * j];
#pragma unroll
                for (int j = 0; j < 4; ++j) { acc[n][0][j] += a.x * b[j]; acc[n][1][j] += a.y * b[j]; acc[n][2][j] += a.z * b[j]; acc[n][3][j] += a.w * b[j]; }
            }
        }
    }
}
__global__ void __launch_bounds__(256) k_ffn_up(const bf16* H, const float* w1, const float* w3, bf16* G) {
    __shared__ float As[16 * 68]; __shared__ float Bs[2 * 16 * 64];
    float acc[2][4][4]; const int row0 = blockIdx.x * 64, col0 = blockIdx.y * 64, ty = threadIdx.x >> 4, tx = threadIdx.x & 15;
    gemm_tile<2>(H, D, w1, w3, FF, D, row0, col0, acc, As, Bs);
#pragma unroll
    for (int i = 0; i < 4; ++i)
#pragma unroll
        for (int j = 0; j < 4; ++j) G[(size_t)(row0 + ty * 4 + i) * FF + col0 + tx + 16 * j] = (bf16)f2bf(silu_f(acc[0][i][j]) * acc[1][i][j]);
}
__global__ void __launch_bounds__(256) k_resid(const bf16* A, int K, const float* W, const float* xs_in, float* xs_out, const float* gate, int ldmod, float scale) {
    __shared__ float As[16 * 68]; __shared__ float Bs[16 * 64];
    float acc[1][4][4]; const int row0 = blockIdx.x * 64, col0 = blockIdx.y * 64, ty = threadIdx.x >> 4, tx = threadIdx.x & 15, b = row0 / SEQ;
    gemm_tile<1>(A, K, W, W, D, K, row0, col0, acc, As, Bs);
#pragma unroll
    for (int i = 0; i < 4; ++i)
#pragma unroll
        for (int j = 0; j < 4; ++j) { const int col = col0 + tx + 16 * j; const size_t o = (size_t)(row0 + ty * 4 + i) * D + col; xs_out[o] = xs_in[o] + scale * gate[(size_t)b * ldmod + col] * acc[0][i][j]; }
}
__global__ void __launch_bounds__(256) k_inproj(const bf16* H, const float* w_in, bf16* Q, size_t region_stride) {
    __shared__ float As[16 * 68]; __shared__ float Bs[16 * 64];
    float acc[1][4][4]; const int row0 = blockIdx.x * 64, ct = blockIdx.y, col0 = ct * 64, ty = threadIdx.x >> 4, tx = threadIdx.x & 15;
    gemm_tile<1>(H, D, w_in, w_in, NIN, D, row0, col0, acc, As, Bs);
    const int region = ct >> 3, lc0 = (ct & 7) * 64;
    bf16* dst = Q + (size_t)region * region_stride;
#pragma unroll
    for (int i = 0; i < 4; ++i) {
        const int row = row0 + ty * 4 + i, t = row & (SEQ - 1);
        float v[4] = {acc[0][i][0], acc[0][i][1], acc[0][i][2], acc[0][i][3]};
        if (region < 2) {
#pragma unroll
            for (int p = 0; p < 2; ++p) {
                const int d = tx + 16 * p; const float inv = 1.0f / powf(10000.0f, (float)(2 * d) / 64.0f); const float ang = (float)t * inv;
                float sn, cs; sincosf(ang, &sn, &cs);
                const float x1 = v[p], x2 = v[p + 2]; v[p] = x1 * cs - x2 * sn; v[p + 2] = x2 * cs + x1 * sn;
            }
            if (region == 0) {
#pragma unroll
                for (int j = 0; j < 4; ++j) v[j] *= QSCALE; }
        }
#pragma unroll
        for (int j = 0; j < 4; ++j) dst[(size_t)row * 512 + lc0 + tx + 16 * j] = (bf16)f2bf(v[j]);
    }
}
__global__ void __launch_bounds__(64) k_attn(const bf16* Q, const bf16* K, const bf16* V, bf16* AO) {
    __shared__ float Ks[64 * 64]; __shared__ float Vs[64 * 128];
    const int blk = blockIdx.x, qt = 63 - (blk & 63), vh = (blk >> 6) & 7, b = blk >> 9, h = vh >> 1, c = vh & 1, lane = threadIdx.x;
    const size_t rowb = (size_t)b * SEQ; const int t = qt * 64 + lane;
    float q[64], o[128]; float m = -INFINITY, l = 0.f;
    { const v4u* qp = (const v4u*)(Q + (rowb + t) * 512 + vh * 64);
#pragma unroll
      for (int i = 0; i < 8; ++i) { float f[8]; unpack8(qp[i], f);
#pragma unroll
          for (int e = 0; e < 8; ++e) q[i * 8 + e] = f[e]; } }
#pragma unroll
    for (int e = 0; e < 128; ++e) o[e] = 0.f;
    for (int kt = 0; kt <= qt; ++kt) {
        __syncthreads();
        for (int i = 0; i < 64; ++i) { const size_t kr = rowb + kt * 64 + i;
            Ks[i * 64 + lane] = bf2f(K[kr * 512 + vh * 64 + lane]); Vs[i * 128 + lane] = bf2f(V[kr * 512 + h * 128 + lane]); Vs[i * 128 + 64 + lane] = bf2f(V[kr * 512 + h * 128 + 64 + lane]); }
        __syncthreads();
        const int jmax = (kt == qt) ? lane : 63;
        for (int j = 0; j < 64; ++j) {
            if (j <= jmax) {
                float s = 0.f;
#pragma unroll
                for (int d = 0; d < 64; d += 4) { const f32x4 kv = *(const f32x4*)(Ks + j * 64 + d); s += q[d] * kv.x + q[d + 1] * kv.y + q[d + 2] * kv.z + q[d + 3] * kv.w; }
                if (s > m) { const float al = exp2f(m - s); l *= al;
#pragma unroll
                    for (int e = 0; e < 128; ++e) o[e] *= al;
                    m = s; }
                const float p = exp2f(s - m); l += p;
#pragma unroll
                for (int e = 0; e < 128; e += 4) { const f32x4 vv = *(const f32x4*)(Vs + j * 128 + e); o[e] += p * vv.x; o[e + 1] += p * vv.y; o[e + 2] += p * vv.z; o[e + 3] += p * vv.w; }
            }
        }
    }
    const float rl = 1.0f / l; bf16* op = AO + (rowb + t) * D + c * 512 + h * 128;
#pragma unroll
    for (int e = 0; e < 128; e += 8) { float f[8];
#pragma unroll
        for (int i = 0; i < 8; ++i) f[i] = o[e + i] * rl;
        *(v4u*)(op + e) = pack8(f); }
}
}
extern "C" void kernel_launch(void* const* d_in, const int* in_sizes, int n_in, void* d_out, int out_size, void* d_ws, size_t ws_size, hipStream_t stream) {
    if (n_in != 25 || in_sizes[0] != M * D || out_size != M * D || ws_size < WS_END) { fprintf(stderr, "kernel_launch: unexpected shapes (n_in %d, in0 %d, out %d, ws %zu)\n", n_in, n_in > 0 ? in_sizes[0] : -1, out_size, ws_size); return; }
    const float* x = (const float*)d_in[0]; const float* c = (const float*)d_in[1];
    const float *w_ada = (const float*)d_in[2], *b_ada = (const float*)d_in[3], *w_adaf = (const float*)d_in[4], *b_adaf = (const float*)d_in[5];
    const float *g_ffn1 = (const float*)d_in[6], *g_mix = (const float*)d_in[7], *g_ffn2 = (const float*)d_in[8], *g_final = (const float*)d_in[9];
    const float *f1w1 = (const float*)d_in[10], *f1w3 = (const float*)d_in[11], *f1w2 = (const float*)d_in[12], *f2w1 = (const float*)d_in[13], *f2w3 = (const float*)d_in[14], *f2w2 = (const float*)d_in[15];
    const float *w_in = (const float*)d_in[16], *lq1 = (const float*)d_in[17], *lk1 = (const float*)d_in[18], *lq2 = (const float*)d_in[19], *lk2 = (const float*)d_in[20];
    const float *subln_g = (const float*)d_in[21], *conv_w = (const float*)d_in[22], *conv_g = (const float*)d_in[23], *w_out = (const float*)d_in[24];
    unsigned char* ws = (unsigned char*)d_ws; float* out = (float*)d_out;
    float *mod = (float*)(ws + WS_MOD), *modf = (float*)(ws + WS_MODF), *lam = (float*)(ws + WS_LAM);
    bf16 *H = (bf16*)(ws + WS_H), *G = (bf16*)(ws + WS_G), *Q = (bf16*)(ws + WS_Q), *Kb = (bf16*)(ws + WS_K), *Vb = (bf16*)(ws + WS_V), *Bb = (bf16*)(ws + WS_B), *Cb = (bf16*)(ws + WS_C), *Ub = (bf16*)(ws + WS_U), *AO = (bf16*)(ws + WS_AO);
    nv::k_ada<<<(BATCH * (NMOD + NMODF) + 255) / 256, 256, 0, stream>>>(c, w_ada, b_ada, w_adaf, b_adaf, mod, modf, lq1, lk1, lq2, lk2, lam);
    nv::k_norm<true><<<M / 64, 256, 0, stream>>>(x, H, g_ffn1, mod + 0 * D, mod + 1 * D, NMOD);
    nv::k_ffn_up<<<dim3(M / 64, FF / 64), 256, 0, stream>>>(H, f1w1, f1w3, G);
    nv::k_resid<<<dim3(M / 64, D / 64), 256, 0, stream>>>(G, FF, f1w2, x, out, mod + 2 * D, NMOD, 0.5f);
    nv::k_norm<true><<<M / 64, 256, 0, stream>>>(out, H, g_mix, mod + 3 * D, mod + 4 * D, NMOD);
    nv::k_inproj<<<dim3(M / 64, NIN / 64), 256, 0, stream>>>(H, w_in, Q, (size_t)M * 512);
    nv::k_attn<<<BATCH * 8 * 64, 64, 0, stream>>>(Q, Kb, Vb, AO);
    nv::k_mix<<<M / 64, 256, 0, stream>>>(AO, Bb, Cb, Ub, H, subln_g, conv_w, conv_g, lam);
    nv::k_resid<<<dim3(M / 64, D / 64), 256, 0, stream>>>(H, D, w_out, out, out, mod + 5 * D, NMOD, 1.0f);
    nv::k_norm<true><<<M / 64, 256, 0, stream>>>(out, H, g_ffn2, mod + 6 * D, mod + 7 * D, NMOD);
    nv::k_ffn_up<<<dim3(M / 64, FF / 64), 256, 0, stream>>>(H, f2w1, f2w3, G);
    nv::k_resid<<<dim3(M / 64, D / 64), 256, 0, stream>>>(G, FF, f2w2, out, out, mod + 8 * D, NMOD, 0.5f);
    nv::k_norm<false><<<M / 64, 256, 0, stream>>>(out, out, g_final, modf + 0, modf + D, NMODF);
}
```

```cpp
#define ATTN_PRIO 3
#include <hip/hip_runtime.h>
#include <cstdio>
#include <cstdint>
#include <cmath>

constexpr int BATCH = 8, SEQ = 4096, D = 1024, M = BATCH * SEQ, FF = 2816, NIN = 3072, AW = 512, CWID = 512;
constexpr int NMOD = 9 * D, NMODF = 2 * D;
constexpr float NORM_EPS = 1e-6f, SUBLN_EPS = 1e-5f, LAMBDA_INIT = 0.2f;
constexpr float QSCALE = 0.125f * 1.4426950408889634f;

constexpr size_t MiB = 1u << 20;
constexpr size_t WS_CTL = 0, CTL_ZERO_BYTES = 128 * 1024;
constexpr int CW_ADA = 24576;
constexpr int CW_CMAX = 8192;
constexpr size_t WS_W13A = 1 * MiB, WS_W2A = 12 * MiB, WS_W13B = 18 * MiB, WS_W2B = 29 * MiB, WS_WIN = 35 * MiB, WS_WOUT = 41 * MiB;
constexpr size_t WS_ROPE = 43 * MiB;
constexpr size_t WS_MOD = 44 * MiB;
constexpr size_t WS_MODF = WS_MOD + (size_t)BATCH * NMOD * 4, WS_LAM = WS_MODF + (size_t)BATCH * NMODF * 4;
constexpr size_t WS_H = 48 * MiB;
constexpr size_t WS_G = 112 * MiB;
constexpr size_t WS_Q = 112 * MiB, WS_K = 144 * MiB, WS_V = 176 * MiB, WS_B = 208 * MiB, WS_C = 240 * MiB, WS_U = 272 * MiB;
constexpr size_t WS_AO = 304 * MiB;
constexpr size_t WS_MIX = 368 * MiB;
constexpr size_t WS_XS1 = 432 * MiB;
constexpr size_t WS_XS2 = WS_AO;
constexpr size_t WS_END = 496 * MiB;
constexpr size_t WS_SHWIN = 45 * MiB;
constexpr size_t WS_CS = WS_SHWIN + (size_t)BATCH * NIN * 4;
constexpr size_t WS_RSS2 = 46 * MiB, WS_RSS3 = WS_RSS2 + (size_t)M * 4, WS_RSS4 = WS_RSS3 + (size_t)M * 4;
constexpr size_t WS_RS1 = WS_RSS4 + 2 * (size_t)M * 4, WS_RS3 = WS_RS1 + (size_t)M * 4;

struct Args { const float* in[25]; float* out; unsigned char* ws; int ph_lo, ph_hi, use_bar, pad; };
typedef unsigned short bf16;
__device__ __forceinline__ float bf2f(unsigned v) { return __uint_as_float(v << 16); }
__device__ __forceinline__ unsigned f2bf(float f) { unsigned u = __float_as_uint(f); return (u + 0x7fffu + ((u >> 16) & 1u)) >> 16; }
__device__ __forceinline__ unsigned pk2(float lo, float hi) { return f2bf(lo) | (f2bf(hi) << 16); }
typedef float f32x4 __attribute__((ext_vector_type(4)));
typedef unsigned v4u __attribute__((ext_vector_type(4)));
typedef unsigned v2u __attribute__((ext_vector_type(2)));

__device__ __forceinline__ int mk_lane() { return (int)__builtin_amdgcn_mbcnt_hi(~0u, __builtin_amdgcn_mbcnt_lo(~0u, 0u)); }
__device__ __forceinline__ float wave_sum(float v) {
#pragma unroll
    for (int o = 1; o < 64; o <<= 1) v += __shfl_xor(v, o);
    return v;
}
__device__ __forceinline__ float silu_f(float v) { return v / (1.0f + __expf(-v)); }

template <bool TOBF>
__device__ __forceinline__ void norm_rows(const float* xs, void* out, const float* g, const float* shv, const float* scv, int r0, int nrows, int lane) {
    f32x4 gm[4], sh[4];
#pragma unroll
    for (int j = 0; j < 4; ++j) { const f32x4 gg = ((const f32x4*)g)[lane + 64 * j], sc = ((const f32x4*)scv)[lane + 64 * j]; gm[j] = gg * (sc + 1.0f); sh[j] = ((const f32x4*)shv)[lane + 64 * j]; }
    f32x4 v[4], w[4];
#pragma unroll
    for (int j = 0; j < 4; ++j) v[j] = ((const f32x4*)(xs + (size_t)r0 * D))[lane + 64 * j];
    for (int r = r0; r < r0 + nrows; ++r) {
        if (r + 1 < r0 + nrows) {
#pragma unroll
            for (int j = 0; j < 4; ++j) w[j] = ((const f32x4*)(xs + (size_t)(r + 1) * D))[lane + 64 * j]; }
        float s = 0.f;
#pragma unroll
        for (int j = 0; j < 4; ++j) s += (v[j].x * v[j].x + v[j].y * v[j].y) + (v[j].z * v[j].z + v[j].w * v[j].w);
        const float rs = 1.0f / sqrtf(wave_sum(s) * (1.f / D) + NORM_EPS);
#pragma unroll
        for (int j = 0; j < 4; ++j) {
            const f32x4 o = v[j] * rs * gm[j] + sh[j];
            if (TOBF) { v2u q; q.x = pk2(o.x, o.y); q.y = pk2(o.z, o.w); ((v2u*)((bf16*)out + (size_t)r * D))[lane + 64 * j] = q; }
            else ((f32x4*)((float*)out + (size_t)r * D))[lane + 64 * j] = o;
        }
#pragma unroll
        for (int j = 0; j < 4; ++j) v[j] = w[j];
    }
}


__device__ __forceinline__ unsigned q8pack(float a, float b, float c4, float d, float inv) {
    const int q0 = (int)rintf(a * inv), q1 = (int)rintf(b * inv), q2 = (int)rintf(c4 * inv), q3 = (int)rintf(d * inv);
    return (unsigned)(q0 & 255) | ((unsigned)(q1 & 255) << 8) | ((unsigned)(q2 & 255) << 16) | ((unsigned)q3 << 24);
}
__device__ __forceinline__ float wave_max(float v) {
#pragma unroll
    for (int o = 1; o < 64; o <<= 1) v = fmaxf(v, __shfl_xor(v, o));
    return v;
}
__device__ __forceinline__ void norm_rows_q8(const float* xs, signed char* H8, float* rs, const float* g, const float* shv, const float* scv, int r0, int nrows, int lane) {
    f32x4 gm[4], sh[4];
#pragma unroll
    for (int j = 0; j < 4; ++j) { const f32x4 gg = ((const f32x4*)g)[lane + 64 * j], sc = ((const f32x4*)scv)[lane + 64 * j]; gm[j] = gg * (sc + 1.0f); sh[j] = ((const f32x4*)shv)[lane + 64 * j]; }
    f32x4 buf[4][4];
#pragma unroll
    for (int q = 0; q < 3; ++q)
#pragma unroll
        for (int j = 0; j < 4; ++j) buf[q][j] = ((const f32x4*)(xs + (size_t)(r0 + q) * D))[lane + 64 * j];
    for (int rr = r0; rr < r0 + nrows; rr += 4) {
#pragma unroll
        for (int q = 0; q < 4; ++q) { const int r = rr + q;
            if (r + 3 < r0 + nrows) {
#pragma unroll
                for (int j = 0; j < 4; ++j) buf[(q + 3) & 3][j] = ((const f32x4*)(xs + (size_t)(r + 3) * D))[lane + 64 * j]; }
            const f32x4 (&v)[4] = buf[q];
            float s = 0.f;
#pragma unroll
            for (int j = 0; j < 4; ++j) s += (v[j].x * v[j].x + v[j].y * v[j].y) + (v[j].z * v[j].z + v[j].w * v[j].w);
            const float rn = 1.0f / sqrtf(wave_sum(s) * (1.f / D) + NORM_EPS);
            f32x4 o[4]; float mx = 0.f;
#pragma unroll
            for (int j = 0; j < 4; ++j) { o[j] = v[j] * rn * gm[j] + sh[j]; mx = fmaxf(fmaxf(mx, fmaxf(fabsf(o[j].x), fabsf(o[j].y))), fmaxf(fabsf(o[j].z), fabsf(o[j].w))); }
            mx = wave_max(mx); const float scale = mx > 0.f ? mx * (1.0f / 127.0f) : 1.0f, inv = 1.0f / scale;
#pragma unroll
            for (int j = 0; j < 4; ++j) ((unsigned*)(H8 + (size_t)r * D))[lane + 64 * j] = q8pack(o[j].x, o[j].y, o[j].z, o[j].w, inv);
            if (lane == 0) rs[r] = scale;
        }
    }
}
__device__ __forceinline__ void norm_rows_q8_bf(const bf16* xs, const float* rss, signed char* H8, float* rs, const float* g, const float* shv, const float* scv, int r0, int nrows, int lane);
__device__ __forceinline__ void unpack8(const v4u w, float (&f)[8]) {
    f[0] = bf2f(w.x & 0xffffu); f[1] = bf2f(w.x >> 16); f[2] = bf2f(w.y & 0xffffu); f[3] = bf2f(w.y >> 16);
    f[4] = bf2f(w.z & 0xffffu); f[5] = bf2f(w.z >> 16); f[6] = bf2f(w.w & 0xffffu); f[7] = bf2f(w.w >> 16);
}
__device__ __forceinline__ v4u pack8(const float (&f)[8]) { v4u w; w.x = pk2(f[0], f[1]); w.y = pk2(f[2], f[3]); w.z = pk2(f[4], f[5]); w.w = pk2(f[6], f[7]); return w; }
__device__ __forceinline__ void conv_rows(const bf16* Bb, const bf16* Cb, const bf16* Ub, bf16* MIX, const float* conv_w, const float* conv_g, int r0, int nrows, int lane) {
    float w0[8], w1[8], w2[8], cg[8];
#pragma unroll
    for (int i = 0; i < 8; ++i) { w0[i] = conv_w[8 * lane + i]; w1[i] = conv_w[CWID + 8 * lane + i]; w2[i] = conv_w[2 * CWID + 8 * lane + i]; cg[i] = conv_g[8 * lane + i]; }
    float cu1[8], cu2[8];
    {
        const int t0 = r0 & (SEQ - 1);
#pragma unroll
        for (int i = 0; i < 8; ++i) { cu1[i] = 0.f; cu2[i] = 0.f; }
        if (t0 >= 1) { float c[8], u[8]; unpack8(((const v4u*)(Cb + (size_t)(r0 - 1) * CWID))[lane], c); unpack8(((const v4u*)(Ub + (size_t)(r0 - 1) * CWID))[lane], u);
#pragma unroll
            for (int i = 0; i < 8; ++i) cu1[i] = c[i] * u[i]; }
        if (t0 >= 2) { float c[8], u[8]; unpack8(((const v4u*)(Cb + (size_t)(r0 - 2) * CWID))[lane], c); unpack8(((const v4u*)(Ub + (size_t)(r0 - 2) * CWID))[lane], u);
#pragma unroll
            for (int i = 0; i < 8; ++i) cu2[i] = c[i] * u[i]; }
    }
    v4u qc = ((const v4u*)(Cb + (size_t)r0 * CWID))[lane], qu = ((const v4u*)(Ub + (size_t)r0 * CWID))[lane], qb = ((const v4u*)(Bb + (size_t)r0 * CWID))[lane];
    for (int r = r0; r < r0 + nrows; ++r) {
        v4u nc, nu, nb;
        if (r + 1 < r0 + nrows) { nc = ((const v4u*)(Cb + (size_t)(r + 1) * CWID))[lane]; nu = ((const v4u*)(Ub + (size_t)(r + 1) * CWID))[lane]; nb = ((const v4u*)(Bb + (size_t)(r + 1) * CWID))[lane]; }
        float c[8], u[8], bb[8], y[8]; unpack8(qc, c); unpack8(qu, u); unpack8(qb, bb);
        float s2 = 0.f;
#pragma unroll
        for (int i = 0; i < 8; ++i) { const float cu0 = c[i] * u[i]; y[i] = bb[i] * (w0[i] * cu2[i] + w1[i] * cu1[i] + w2[i] * cu0); cu2[i] = cu1[i]; cu1[i] = cu0; s2 += y[i] * y[i]; }
        s2 += __shfl_xor(s2, 1); s2 += __shfl_xor(s2, 2); s2 += __shfl_xor(s2, 4);
        const float rc = 1.0f / sqrtf(s2 * (1.f / 64.f) + NORM_EPS);
#pragma unroll
        for (int i = 0; i < 8; ++i) y[i] = y[i] * rc * cg[i];
        ((v4u*)(MIX + (size_t)r * D + AW))[lane] = pack8(y);
        qc = nc; qu = nu; qb = nb;
    }
}
struct Conv4 { v4u qc[6], qu[6], qb[4]; };
__device__ __forceinline__ void conv4_load(Conv4& Q, const bf16* Bb, const bf16* Cb, const bf16* Ub, int r0, int lane) {
    const bool halo = (r0 & (SEQ - 1)) != 0;
#pragma unroll
    for (int k = 0; k < 6; ++k) { const int r = r0 - 2 + k; if (k >= 2 || halo) { Q.qc[k] = ((const v4u*)(Cb + (size_t)r * CWID))[lane]; Q.qu[k] = ((const v4u*)(Ub + (size_t)r * CWID))[lane]; } else { Q.qc[k] = (v4u){0u, 0u, 0u, 0u}; Q.qu[k] = (v4u){0u, 0u, 0u, 0u}; } }
#pragma unroll
    for (int k = 0; k < 4; ++k) Q.qb[k] = ((const v4u*)(Bb + (size_t)(r0 + k) * CWID))[lane];
}
__device__ __forceinline__ void conv4_finish(const Conv4& Q, bf16* MIX, const float* conv_w, const float* conv_g, int r0, int lane) {
    float w0[8], w1[8], w2[8], cg[8];
#pragma unroll
    for (int i = 0; i < 8; ++i) { w0[i] = conv_w[8 * lane + i]; w1[i] = conv_w[CWID + 8 * lane + i]; w2[i] = conv_w[2 * CWID + 8 * lane + i]; cg[i] = conv_g[8 * lane + i]; }
    float cu2[8], cu1[8];
    { float c[8], u[8]; unpack8(Q.qc[0], c); unpack8(Q.qu[0], u);
#pragma unroll
      for (int i = 0; i < 8; ++i) cu2[i] = c[i] * u[i];
      unpack8(Q.qc[1], c); unpack8(Q.qu[1], u);
#pragma unroll
      for (int i = 0; i < 8; ++i) cu1[i] = c[i] * u[i]; }
#pragma unroll
    for (int k = 0; k < 4; ++k) {
        float c[8], u[8], bb[8], y[8]; unpack8(Q.qc[k + 2], c); unpack8(Q.qu[k + 2], u); unpack8(Q.qb[k], bb);
        float s2 = 0.f;
#pragma unroll
        for (int i = 0; i < 8; ++i) { const float cu0 = c[i] * u[i]; y[i] = bb[i] * (w0[i] * cu2[i] + w1[i] * cu1[i] + w2[i] * cu0); cu2[i] = cu1[i]; cu1[i] = cu0; s2 += y[i] * y[i]; }
        s2 += __shfl_xor(s2, 1); s2 += __shfl_xor(s2, 2); s2 += __shfl_xor(s2, 4);
        const float rc = 1.0f / sqrtf(s2 * (1.f / 64.f) + NORM_EPS);
#pragma unroll
        for (int i = 0; i < 8; ++i) y[i] = y[i] * rc * cg[i];
        ((v4u*)(MIX + (size_t)(r0 + k) * D + AW))[lane] = pack8(y);
    }
}
__device__ __forceinline__ void norm_rows_q8_bf(const bf16* xs, const float* rss, signed char* H8, float* rs, const float* g, const float* shv, const float* scv, int r0, int nrows, int lane) {
    float gm[16], sh[16];
#pragma unroll
    for (int j = 0; j < 2; ++j)
#pragma unroll
        for (int e = 0; e < 8; ++e) { const int cidx = 512 * j + 8 * lane + e; gm[8 * j + e] = g[cidx] * (scv[cidx] + 1.0f); sh[8 * j + e] = shv[cidx]; }
    v4u q0 = *(const v4u*)(xs + (size_t)r0 * D + 8 * lane), q1 = *(const v4u*)(xs + (size_t)r0 * D + 512 + 8 * lane); float ssq = rss[r0];
    for (int r = r0; r < r0 + nrows; ++r) { v4u n0, n1; float nss;
        if (r + 1 < r0 + nrows) { n0 = *(const v4u*)(xs + (size_t)(r + 1) * D + 8 * lane); n1 = *(const v4u*)(xs + (size_t)(r + 1) * D + 512 + 8 * lane); nss = rss[r + 1]; }
        const float rn = 1.0f / sqrtf(ssq * (1.f / D) + NORM_EPS);
        float o[16]; float mx = 0.f;
        { float f[8]; unpack8(q0, f);
#pragma unroll
          for (int e = 0; e < 8; ++e) { o[e] = f[e] * rn * gm[e] + sh[e]; mx = fmaxf(mx, fabsf(o[e])); }
          unpack8(q1, f);
#pragma unroll
          for (int e = 0; e < 8; ++e) { o[8 + e] = f[e] * rn * gm[8 + e] + sh[8 + e]; mx = fmaxf(mx, fabsf(o[8 + e])); } }
        mx = wave_max(mx); const float scale = mx > 0.f ? mx * (1.0f / 127.0f) : 1.0f, inv = 1.0f / scale;
#pragma unroll
        for (int j = 0; j < 2; ++j) { v2u w; w.x = q8pack(o[8 * j], o[8 * j + 1], o[8 * j + 2], o[8 * j + 3], inv); w.y = q8pack(o[8 * j + 4], o[8 * j + 5], o[8 * j + 6], o[8 * j + 7], inv);
            *(v2u*)(H8 + (size_t)r * D + 512 * j + 8 * lane) = w; }
        if (lane == 0) rs[r] = scale;
        q0 = n0; q1 = n1; ssq = nss;
    }
}
__device__ __forceinline__ float lam_value(const float* lq1, const float* lk1, const float* lq2, const float* lk2) {
    float s1 = 0.f, s2 = 0.f;
    for (int i = 0; i < 64; ++i) { s1 += lq1[i] * lk1[i]; s2 += lq2[i] * lk2[i]; }
    return expf(s1) - expf(s2) + LAMBDA_INIT;
}
namespace pg8 {
#define PG8_LAS __attribute__((address_space(3)))
typedef unsigned short bf16_t;
typedef short bf16x8 __attribute__((ext_vector_type(8)));
typedef float f32x4 __attribute__((ext_vector_type(4)));
typedef unsigned u32x4 __attribute__((ext_vector_type(4)));
constexpr int BM = 256, BK = 64, HALF = 128, HTB = HALF * BK * 2  , STAGE_BYTES = 8 * HTB, NXCD = 8, WGM = 8;
constexpr int SIDE_REL = STAGE_BYTES + 1024;

__host__ __device__ __forceinline__ int lds_byte(int r, int c) { const int st = (r >> 4) * 2 + (c >> 5), rr = r & 15, cc = c & 31, ob = rr * 64 + cc * 2; return st * 1024 + (ob ^ (((ob >> 9) & 1) << 5)); }
__host__ __device__ __forceinline__ void stage_rc(int b, int& R, int& C) { const int st = b / 1024, sb = b % 1024, swz = sb ^ (((sb >> 9) & 1) << 5); R = (st >> 1) * 16 + swz / 64; C = (st & 1) * 32 + (swz % 64) / 2; }
__host__ __device__ __forceinline__ int perm32(int rho) { const int n = rho >> 4, i = rho & 15; return 8 * (i >> 2) + 4 * n + (i & 3); }

struct Unit { int pm, pn; };
struct Gemm { const bf16_t* A; const bf16_t* Bt; int M, N, K; };

struct StaticOrder {
    int nM, nN, nwg, G, c;
    __host__ __device__ void init(int M, int N, int G_, int c_) { nM = M / BM; nN = N / BM; nwg = nM * nN; G = G_; c = c_; }
    __host__ __device__ bool next(int i, Unit& u) const {
        const long L = (long)i * G + c; if (L >= nwg) return false;
        int wgid = (int)L; { const int q = nwg / NXCD, r = nwg % NXCD, xcd = wgid % NXCD, off = wgid / NXCD; wgid = (xcd < r ? xcd * (q + 1) : r * (q + 1) + (xcd - r) * q) + off; }
        const int nig = WGM * nN, gid = wgid / nig, fm = gid * WGM, gsz = (nM - fm) < WGM ? (nM - fm) : WGM;
        u.pm = fm + ((wgid % nig) % gsz); u.pn = (wgid % nig) / gsz; return true;
    }
    __device__ __forceinline__ void a_ready(const Unit&) const {}
    __device__ __forceinline__ void done(const Unit&) const {}
};

__device__ __forceinline__ unsigned cvt_pk_bf16(float lo, float hi) { unsigned r; asm volatile("v_cvt_pk_bf16_f32 %0, %1, %2" : "=v"(r) : "v"(lo), "v"(hi)); return r; }
typedef int i32x4 __attribute__((ext_vector_type(4)));
#ifdef WT_STORES
__device__ __forceinline__ void st16(void* p, u32x4 v) { asm volatile("global_store_dwordx4 %0, %1, off sc1\n\ts_nop 1" :: "v"(p), "v"(v) : "memory"); }
#else
__device__ __forceinline__ void st16(void* p, u32x4 v) { *(u32x4*)p = v; }
#endif
template <class E, class = void> struct AccOf { typedef f32x4 type; };
template <class E> struct AccOf<E, typename E::i8_tag> { typedef i32x4 type; };
template <class E, class = void> struct ZeroByMov { static constexpr bool v = false; };
template <class E> struct ZeroByMov<E, typename E::zmov_tag> { static constexpr bool v = true; };
__device__ __forceinline__ f32x4 mma16(bf16x8 b, bf16x8 a, f32x4 c) { return __builtin_amdgcn_mfma_f32_16x16x32_bf16(b, a, c, 0, 0, 0); }
__device__ __forceinline__ i32x4 mma16(bf16x8 b, bf16x8 a, i32x4 c) { return __builtin_amdgcn_mfma_i32_16x16x64_i8(__builtin_bit_cast(i32x4, b), __builtin_bit_cast(i32x4, a), c, 0, 0, 0); }
typedef const __attribute__((address_space(4))) ::Args* kargs_ptr;
__device__ __forceinline__ kargs_ptr kargs_fresh() { kargs_ptr p = (kargs_ptr)__builtin_amdgcn_kernarg_segment_ptr(); asm volatile("" : "+s"(p)); return p; }
__device__ __forceinline__ float sum_fq(float v) {
    { auto r = __builtin_amdgcn_permlane16_swap(__float_as_uint(v), __float_as_uint(v), false, false); v = __uint_as_float(r[0]) + __uint_as_float(r[1]); }
    { auto r = __builtin_amdgcn_permlane32_swap(__float_as_uint(v), __float_as_uint(v), false, false); v = __uint_as_float(r[0]) + __uint_as_float(r[1]); }
    return v;
}
__device__ __forceinline__ float silu_fast(float v) { return v * __builtin_amdgcn_rcpf(1.0f + __builtin_amdgcn_exp2f(v * -1.4426950408889634f)); }
__device__ __forceinline__ float rs_of(float ss) { return __builtin_amdgcn_rsqf(ss * (1.0f / 1024.0f) + 1e-6f); }
#ifndef NO_SIDE_LDS
#define SIDE_LDS 1
#define SIDE_LDS_Z 1
#define EPIZ_PEEL 1
#endif
#ifndef NO_SWIGLU_V2
#define SWIGLU_V2 1
#endif
template <int WHICH, int EABL = 0> struct EpiSwiGLUq {
    typedef void i8_tag; static constexpr bool PERM = true, AFTER_DRAIN = false;
#ifdef SIDE_LDS
    static constexpr bool SIDE = true;
#else
    static constexpr bool SIDE = false;
#endif
    static __device__ __forceinline__ const char* side_src(const Unit& u, int wid) { unsigned char* ws = kargs_fresh()->ws;
        const float* rs = (const float*)(ws + (WHICH == 0 ? WS_RS1 : WS_RS3)); const float* cs = (const float*)(ws + WS_CS) + WHICH * 2 * FF;
        return (const char*)(wid < 4 ? rs + u.pm * BM + 64 * wid : cs + u.pn * BM + 64 * (wid - 4)); }
    __device__ __forceinline__ void operator()(const i32x4 (&acc)[2][2][4][2], const Unit& u, int wr, int wc, int fr, int fq, PG8_LAS unsigned char* sb = nullptr) const {
        unsigned char* ws = kargs_fresh()->ws; bf16_t* O = (bf16_t*)(ws + WS_G); constexpr int ldc = FF;
        const float* rs = (const float*)(ws + (WHICH == 0 ? WS_RS1 : WS_RS3)); const float* cs = (const float*)(ws + WS_CS) + WHICH * 2 * FF;
        const int row0 = u.pm * BM + wr * 64 + fr, col0 = u.pn * HALF + wc * 32 + 8 * fq, bcol0 = u.pn * BM + wc * 32 + 8 * fq;
        f32x4 c1[2], c3[2]; float rr[8];
        if (EABL == 1 || EABL == 5) {
#pragma unroll
            for (int n = 0; n < 2; ++n) { c1[n] = (f32x4){0.001f, 0.002f, 0.003f, 0.001f} * (float)(fr + 1); c3[n] = (f32x4){0.002f, 0.001f, 0.003f, 0.002f} * (float)(fq + 1); }
#pragma unroll
            for (int g = 0; g < 8; ++g) rr[g] = 0.01f * (float)(g + 1 + fr);
        } else if (SIDE) {
#pragma unroll
            for (int n = 0; n < 2; ++n) { c1[n] = *(const PG8_LAS f32x4*)(sb + 1024 + 4 * (wc * 32 + 8 * fq + 4 * n)); c3[n] = *(const PG8_LAS f32x4*)(sb + 1024 + 4 * (HALF + wc * 32 + 8 * fq + 4 * n)); }
#pragma unroll
            for (int g = 0; g < 8; ++g) rr[g] = *(const PG8_LAS float*)(sb + 4 * (wr * 64 + fr + (g >> 2) * HALF + (g & 3) * 16));
        } else {
#pragma unroll
        for (int n = 0; n < 2; ++n) { c1[n] = *(const f32x4*)(cs + bcol0 + 4 * n); c3[n] = *(const f32x4*)(cs + bcol0 + HALF + 4 * n); }
#pragma unroll
        for (int g = 0; g < 8; ++g) rr[g] = rs[row0 + (g >> 2) * HALF + (g & 3) * 16];
        }
#ifdef SWIGLU_V2
        f32x4 c1l[2], c13[2];
#pragma unroll
        for (int n = 0; n < 2; ++n) { c1l[n] = c1[n] * -1.4426950408889634f; c13[n] = c1[n] * c3[n]; }
#pragma unroll
        for (int ai = 0; ai < 2; ++ai)
#pragma unroll
            for (int m = 0; m < 4; ++m) { bf16_t* rowp = O + (size_t)(row0 + ai * HALF + m * 16) * ldc + col0; const float r = rr[ai * 4 + m], r2 = r * r;
                u32x4 w; unsigned wv[4];
#pragma unroll
                for (int n = 0; n < 2; ++n) { const i32x4 ia = acc[ai][0][m][n], ib = acc[ai][1][m][n];
                    const f32x4 fa = (f32x4){(float)ia[0], (float)ia[1], (float)ia[2], (float)ia[3]}, fb = (f32x4){(float)ib[0], (float)ib[1], (float)ib[2], (float)ib[3]};
                    f32x4 o;
                    if (EABL == 3) o = fa + fb; else {
                    const f32x4 t = fa * (c1l[n] * r); const f32x4 p = (fa * fb) * (c13[n] * r2);
                    const f32x4 d = (f32x4){__builtin_amdgcn_exp2f(t[0]), __builtin_amdgcn_exp2f(t[1]), __builtin_amdgcn_exp2f(t[2]), __builtin_amdgcn_exp2f(t[3])} + 1.0f;
                    o = p * (f32x4){__builtin_amdgcn_rcpf(d[0]), __builtin_amdgcn_rcpf(d[1]), __builtin_amdgcn_rcpf(d[2]), __builtin_amdgcn_rcpf(d[3])}; }
                    wv[2 * n] = cvt_pk_bf16(o[0], o[1]); wv[2 * n + 1] = cvt_pk_bf16(o[2], o[3]); }
                w.x = wv[0]; w.y = wv[1]; w.z = wv[2]; w.w = wv[3];
                if (EABL == 2 || EABL == 5) asm volatile("" :: "v"(w.x), "v"(w.y), "v"(w.z), "v"(w.w)); else st16(rowp, w); }
#else
#pragma unroll
        for (int ai = 0; ai < 2; ++ai)
#pragma unroll
            for (int m = 0; m < 4; ++m) { bf16_t* rowp = O + (size_t)(row0 + ai * HALF + m * 16) * ldc + col0; const float r = rr[ai * 4 + m];
                const i32x4 ia0 = acc[ai][0][m][0], ia1 = acc[ai][0][m][1], ib0 = acc[ai][1][m][0], ib1 = acc[ai][1][m][1];
                const f32x4 a0 = (f32x4){(float)ia0[0], (float)ia0[1], (float)ia0[2], (float)ia0[3]} * r * c1[0], a1 = (f32x4){(float)ia1[0], (float)ia1[1], (float)ia1[2], (float)ia1[3]} * r * c1[1];
                const f32x4 b0 = (f32x4){(float)ib0[0], (float)ib0[1], (float)ib0[2], (float)ib0[3]} * r * c3[0], b1 = (f32x4){(float)ib1[0], (float)ib1[1], (float)ib1[2], (float)ib1[3]} * r * c3[1];
                u32x4 w;
                w.x = cvt_pk_bf16(silu_fast(a0[0]) * b0[0], silu_fast(a0[1]) * b0[1]); w.y = cvt_pk_bf16(silu_fast(a0[2]) * b0[2], silu_fast(a0[3]) * b0[3]);
                w.z = cvt_pk_bf16(silu_fast(a1[0]) * b1[0], silu_fast(a1[1]) * b1[1]); w.w = cvt_pk_bf16(silu_fast(a1[2]) * b1[2], silu_fast(a1[3]) * b1[3]);
                *(u32x4*)rowp = w; }
#endif
    }
    static constexpr int PEND_LD = FF * 2;
    static __device__ __forceinline__ constexpr size_t pend_off(int j) { return (size_t)((j >> 2) * HALF + (j & 3) * 16) * FF * 2; }
    __device__ __forceinline__ char* compute(const i32x4 (&acc)[2][2][4][2], const Unit& u, int wr, int wc, int fr, int fq, u32x4 (&pend)[8]) const {
        unsigned char* ws = kargs_fresh()->ws; bf16_t* O = (bf16_t*)(ws + WS_G); constexpr int ldc = FF;
        const float* rs = (const float*)(ws + (WHICH == 0 ? WS_RS1 : WS_RS3)); const float* cs = (const float*)(ws + WS_CS) + WHICH * 2 * FF;
        const int row0 = u.pm * BM + wr * 64 + fr, col0 = u.pn * HALF + wc * 32 + 8 * fq, bcol0 = u.pn * BM + wc * 32 + 8 * fq;
        f32x4 c1[2], c3[2]; float rr[8];
#pragma unroll
        for (int n = 0; n < 2; ++n) { c1[n] = *(const f32x4*)(cs + bcol0 + 4 * n); c3[n] = *(const f32x4*)(cs + bcol0 + HALF + 4 * n); }
#pragma unroll
        for (int g = 0; g < 8; ++g) rr[g] = rs[row0 + (g >> 2) * HALF + (g & 3) * 16];
#pragma unroll
        for (int ai = 0; ai < 2; ++ai)
#pragma unroll
            for (int m = 0; m < 4; ++m) { const float r = rr[ai * 4 + m];
                const i32x4 ia0 = acc[ai][0][m][0], ia1 = acc[ai][0][m][1], ib0 = acc[ai][1][m][0], ib1 = acc[ai][1][m][1];
                const f32x4 a0 = (f32x4){(float)ia0[0], (float)ia0[1], (float)ia0[2], (float)ia0[3]} * r * c1[0], a1 = (f32x4){(float)ia1[0], (float)ia1[1], (float)ia1[2], (float)ia1[3]} * r * c1[1];
                const f32x4 b0 = (f32x4){(float)ib0[0], (float)ib0[1], (float)ib0[2], (float)ib0[3]} * r * c3[0], b1 = (f32x4){(float)ib1[0], (float)ib1[1], (float)ib1[2], (float)ib1[3]} * r * c3[1];
                u32x4 w;
                w.x = cvt_pk_bf16(silu_fast(a0[0]) * b0[0], silu_fast(a0[1]) * b0[1]); w.y = cvt_pk_bf16(silu_fast(a0[2]) * b0[2], silu_fast(a0[3]) * b0[3]);
                w.z = cvt_pk_bf16(silu_fast(a1[0]) * b1[0], silu_fast(a1[1]) * b1[1]); w.w = cvt_pk_bf16(silu_fast(a1[2]) * b1[2], silu_fast(a1[3]) * b1[3]);
                pend[ai * 4 + m] = w; }
        return (char*)(O + (size_t)(u.pm * BM + wr * 64) * ldc + (u.pn * HALF + wc * 32));
    }
};
template <int WHICH, bool DUMMY_RSS = false> struct EpiResidN {
    static constexpr bool PERM = true, AFTER_DRAIN = false, SIDE = false, BASE_F32 = (WHICH == 0), WRITE_XG = (WHICH == 0);
#ifndef RESID_CH_F32
#define RESID_CH_F32 2
#endif
#ifndef RESID_CH_BF
#define RESID_CH_BF 4
#endif
    static constexpr int CH = BASE_F32 ? RESID_CH_F32 : RESID_CH_BF;
    struct Chunk { f32x4 f[CH][2][2]; u32x4 h[CH][2]; };
    __device__ __forceinline__ void load_chunk(Chunk& C, const void* base, int row0, int col0, int g0) const {
#pragma unroll
        for (int q = 0; q < CH; ++q) { const int gi = g0 + q; const size_t off = (size_t)(row0 + (gi >> 2) * HALF + (gi & 3) * 16) * 1024 + col0;
            if (BASE_F32) {
#pragma unroll
                for (int bj = 0; bj < 2; ++bj)
#pragma unroll
                    for (int n = 0; n < 2; ++n) C.f[q][bj][n] = *(const f32x4*)((const float*)base + off + bj * HALF + 4 * n);
            } else {
#pragma unroll
                for (int bj = 0; bj < 2; ++bj) C.h[q][bj] = *(const u32x4*)((const bf16_t*)base + off + bj * HALF);
            } }
    }
    __device__ __forceinline__ void operator()(const f32x4 (&acc)[2][2][4][2], const Unit& u, int wr, int wc, int fr, int fq) const {
        const kargs_ptr ka = kargs_fresh(); unsigned char* ws = ka->ws; const float* mod = (const float*)(ws + WS_MOD); constexpr int ldmod = NMOD;
        const void* base = WHICH == 0 ? (const void*)ka->in[0] : (const void*)(ws + (WHICH == 1 ? WS_XS1 : WS_XS2));
        bf16_t* xs_out = (bf16_t*)(ws + (WHICH == 1 ? WS_XS2 : WS_XS1)); bf16_t* xg = (bf16_t*)(ws + WS_H);
        const float* gate = mod + (WHICH == 0 ? 2 : WHICH == 1 ? 5 : 8) * D; const float scale = WHICH == 1 ? 1.0f : 0.5f;
        const float* g = WHICH == 0 ? ka->in[7] : ka->in[8]; const float* sc = mod + (WHICH == 0 ? 4 : 7) * D;
        float* rss = (float*)(ws + (DUMMY_RSS ? WS_RSS4 + (size_t)M * 4 : WHICH == 0 ? WS_RSS2 : WHICH == 1 ? WS_RSS3 : WS_RSS4));
        const int row0 = u.pm * BM + wr * 64 + fr, col0 = u.pn * BM + wc * 32 + 8 * fq, b = u.pm >> 4;
        Chunk ck;
        load_chunk(ck, base, row0, col0, 0);
        f32x4 gv[2][2], gm[2][2];
#pragma unroll
        for (int bj = 0; bj < 2; ++bj)
#pragma unroll
            for (int n = 0; n < 2; ++n) { const int c = col0 + bj * HALF + 4 * n; gv[bj][n] = *(const f32x4*)(gate + (size_t)b * ldmod + c) * scale;
                if (WRITE_XG) gm[bj][n] = *(const f32x4*)(g + c) * (*(const f32x4*)(sc + (size_t)b * ldmod + c) + 1.0f); }
#pragma unroll
        for (int g0 = 0; g0 < 8; g0 += CH) {
            if (g0 > 0) load_chunk(ck, base, row0, col0, g0);
#pragma unroll
            for (int q = 0; q < CH; ++q) { const int gi = g0 + q, ai = gi >> 2, m = gi & 3, row = row0 + ai * HALF + m * 16; const size_t off = (size_t)row * 1024 + col0;
                float ss = 0.f;
#pragma unroll
                for (int bj = 0; bj < 2; ++bj) {
                    f32x4 b0, b1;
                    if (BASE_F32) { b0 = ck.f[q][bj][0]; b1 = ck.f[q][bj][1]; }
                    else { const u32x4 hh = ck.h[q][bj]; b0 = (f32x4){__uint_as_float(hh.x << 16), __uint_as_float(hh.x & 0xffff0000u), __uint_as_float(hh.y << 16), __uint_as_float(hh.y & 0xffff0000u)};
                           b1 = (f32x4){__uint_as_float(hh.z << 16), __uint_as_float(hh.z & 0xffff0000u), __uint_as_float(hh.w << 16), __uint_as_float(hh.w & 0xffff0000u)}; }
                    const f32x4 v0 = b0 + gv[bj][0] * acc[ai][bj][m][0], v1 = b1 + gv[bj][1] * acc[ai][bj][m][1];
                    u32x4 w; w.x = cvt_pk_bf16(v0[0], v0[1]); w.y = cvt_pk_bf16(v0[2], v0[3]); w.z = cvt_pk_bf16(v1[0], v1[1]); w.w = cvt_pk_bf16(v1[2], v1[3]);
                    st16(xs_out + off + bj * HALF, w);
                    const f32x4 r0 = (f32x4){__uint_as_float(w.x << 16), __uint_as_float(w.x & 0xffff0000u), __uint_as_float(w.y << 16), __uint_as_float(w.y & 0xffff0000u)};
                    const f32x4 r1 = (f32x4){__uint_as_float(w.z << 16), __uint_as_float(w.z & 0xffff0000u), __uint_as_float(w.w << 16), __uint_as_float(w.w & 0xffff0000u)};
                    ss += (r0[0] * r0[0] + r0[1] * r0[1]) + (r0[2] * r0[2] + r0[3] * r0[3]) + (r1[0] * r1[0] + r1[1] * r1[1]) + (r1[2] * r1[2] + r1[3] * r1[3]);
                    if (WRITE_XG) { const f32x4 y0 = r0 * gm[bj][0], y1 = r1 * gm[bj][1]; u32x4 q2; q2.x = cvt_pk_bf16(y0[0], y0[1]); q2.y = cvt_pk_bf16(y0[2], y0[3]); q2.z = cvt_pk_bf16(y1[0], y1[1]); q2.w = cvt_pk_bf16(y1[2], y1[3]);
                        st16(xg + off + bj * HALF, q2); }
                }
                ss = sum_fq(ss);
                if (fq == 0) (void)__hip_atomic_fetch_add(rss + row, ss, __ATOMIC_RELAXED, __HIP_MEMORY_SCOPE_AGENT);
            }
        }
    }
};
struct EpiZ {
#ifndef EPIZ_PEEL
    typedef void zmov_tag;
#endif
#ifdef SIDE_LDS_Z
    static constexpr bool PERM = true, AFTER_DRAIN = false, SIDE = true;
#else
    static constexpr bool PERM = true, AFTER_DRAIN = false, SIDE = false;
#endif
    static __device__ __forceinline__ const char* side_src(const Unit& u, int wid) { unsigned char* ws = kargs_fresh()->ws;
        const float* rss = (const float*)(ws + WS_RSS2); const float* shw = (const float*)(ws + WS_SHWIN);
        return (const char*)(wid < 4 ? rss + u.pm * BM + 64 * wid : shw + (size_t)(u.pm >> 4) * NIN + u.pn * BM + 64 * (wid - 4)); }
    __device__ __forceinline__ void operator()(const f32x4 (&acc)[2][2][4][2], const Unit& u, int wr, int wc, int fr, int fq, PG8_LAS unsigned char* sb = nullptr) const {
        unsigned char* ws = kargs_fresh()->ws; bf16_t* Q = (bf16_t*)(ws + WS_Q); constexpr size_t region_stride = (size_t)M * 512; const float* rope = (const float*)(ws + WS_ROPE);
        constexpr float qscale = QSCALE; const float* rss = (const float*)(ws + WS_RSS2); const float* shw = (const float*)(ws + WS_SHWIN); constexpr int ldshw = NIN;
        const int row0 = u.pm * BM + wr * 64 + fr, region = u.pn >> 1, b = u.pm >> 4, bcol0 = u.pn * BM + wc * 32 + 8 * fq;
        bf16_t* base = Q + (size_t)region * region_stride;
        f32x4 sw[2][2]; float rr[8];
        if (SIDE) {
#pragma unroll
            for (int bj = 0; bj < 2; ++bj)
#pragma unroll
                for (int n = 0; n < 2; ++n) sw[bj][n] = *(const PG8_LAS f32x4*)(sb + 1024 + 4 * (bj * HALF + wc * 32 + 8 * fq + 4 * n));
#pragma unroll
            for (int g = 0; g < 8; ++g) rr[g] = *(const PG8_LAS float*)(sb + 4 * (wr * 64 + fr + (g >> 2) * HALF + (g & 3) * 16));
        } else {
#pragma unroll
        for (int bj = 0; bj < 2; ++bj)
#pragma unroll
            for (int n = 0; n < 2; ++n) sw[bj][n] = *(const f32x4*)(shw + (size_t)b * ldshw + bcol0 + bj * HALF + 4 * n);
#pragma unroll
        for (int g = 0; g < 8; ++g) rr[g] = rss[row0 + (g >> 2) * HALF + (g & 3) * 16];
        }
#pragma unroll
        for (int g = 0; g < 8; ++g) rr[g] = rs_of(rr[g]);
        if (u.pn < 4) {
            const float sc = (region == 0) ? qscale : 1.0f;
            const int col0 = (u.pn & 1) * 256 + wc * 64 + 8 * fq;
#ifndef ROPE_AHEAD
#define ROPE_AHEAD 1
#endif
            constexpr int RA = ROPE_AHEAD;
            f32x4 ring[RA + 1][4];
#pragma unroll
            for (int q = 0; q < RA; ++q) { const int rowq = row0 + (q >> 2) * HALF + (q & 3) * 16; const f32x4* rp = (const f32x4*)(rope + ((size_t)(rowq & 4095) * 32 + 8 * fq) * 2);
                ring[q][0] = rp[0]; ring[q][1] = rp[1]; ring[q][2] = rp[2]; ring[q][3] = rp[3]; }
#pragma unroll
            for (int g = 0; g < 8; ++g) { const int ai = g >> 2, m = g & 3, row = row0 + ai * HALF + m * 16;
                if (g + RA < 8) { const int gn = g + RA, row2 = row0 + (gn >> 2) * HALF + (gn & 3) * 16; const f32x4* rp = (const f32x4*)(rope + ((size_t)(row2 & 4095) * 32 + 8 * fq) * 2);
                    ring[gn % (RA + 1)][0] = rp[0]; ring[gn % (RA + 1)][1] = rp[1]; ring[gn % (RA + 1)][2] = rp[2]; ring[gn % (RA + 1)][3] = rp[3]; }
                const f32x4 r0 = ring[g % (RA + 1)][0], r1 = ring[g % (RA + 1)][1], r2 = ring[g % (RA + 1)][2], r3 = ring[g % (RA + 1)][3];
                const float r = rr[g];
                const f32x4 x10 = acc[ai][0][m][0] * r + sw[0][0], x11 = acc[ai][0][m][1] * r + sw[0][1], x20 = acc[ai][1][m][0] * r + sw[1][0], x21 = acc[ai][1][m][1] * r + sw[1][1];
                u32x4 w1, w2;
                w1.x = cvt_pk_bf16((x10[0] * r0[0] - x20[0] * r0[1]) * sc, (x10[1] * r0[2] - x20[1] * r0[3]) * sc); w1.y = cvt_pk_bf16((x10[2] * r1[0] - x20[2] * r1[1]) * sc, (x10[3] * r1[2] - x20[3] * r1[3]) * sc);
                w1.z = cvt_pk_bf16((x11[0] * r2[0] - x21[0] * r2[1]) * sc, (x11[1] * r2[2] - x21[1] * r2[3]) * sc); w1.w = cvt_pk_bf16((x11[2] * r3[0] - x21[2] * r3[1]) * sc, (x11[3] * r3[2] - x21[3] * r3[3]) * sc);
                w2.x = cvt_pk_bf16((x20[0] * r0[0] + x10[0] * r0[1]) * sc, (x20[1] * r0[2] + x10[1] * r0[3]) * sc); w2.y = cvt_pk_bf16((x20[2] * r1[0] + x10[2] * r1[1]) * sc, (x20[3] * r1[2] + x10[3] * r1[3]) * sc);
                w2.z = cvt_pk_bf16((x21[0] * r2[0] + x11[0] * r2[1]) * sc, (x21[1] * r2[2] + x11[1] * r2[3]) * sc); w2.w = cvt_pk_bf16((x21[2] * r3[0] + x11[2] * r3[1]) * sc, (x21[3] * r3[2] + x11[3] * r3[3]) * sc);
                bf16_t* rowp = base + (size_t)row * 512 + col0;
                st16(rowp, w1); st16(rowp + 32, w2); }
        } else {
            const int col0 = (u.pn & 1) * 256 + wc * 32 + 8 * fq;
#pragma unroll
            for (int ai = 0; ai < 2; ++ai)
#pragma unroll
                for (int m = 0; m < 4; ++m) { bf16_t* rowp = base + (size_t)(row0 + ai * HALF + m * 16) * 512 + col0; const float r = rr[ai * 4 + m];
#pragma unroll
                    for (int bj = 0; bj < 2; ++bj) { const f32x4 v0 = acc[ai][bj][m][0] * r + sw[bj][0], v1 = acc[ai][bj][m][1] * r + sw[bj][1]; u32x4 w; w.x = cvt_pk_bf16(v0[0], v0[1]); w.y = cvt_pk_bf16(v0[2], v0[3]); w.z = cvt_pk_bf16(v1[0], v1[1]); w.w = cvt_pk_bf16(v1[2], v1[3]);
                        st16(rowp + bj * HALF, w); } }
        }
    }
};
template <int IMM> __device__ __forceinline__ void glds16s(const void* sbase, unsigned voff, unsigned lds_base) { unsigned keep;
    asm volatile("s_nop 4\n\ts_mov_b32 %0, m0\n\ts_add_u32 m0, %3, %4\n\ts_nop 0\n\tglobal_load_lds_dwordx4 %1, %2\n\ts_mov_b32 m0, %0" : "=&s"(keep) : "v"(voff), "s"(sbase), "s"(lds_base), "n"(IMM) : "memory", "scc"); }
template <class Epi, class Sched, bool ALIGN_EPI = false, bool SP2 = false, int ABL = 0, bool AG32 = false>
__device__ __forceinline__ void gemm_phase(PG8_LAS unsigned char* lds, const Gemm g, const Sched& S, const Epi& E, const int wave_id) {
    const int lane = ::mk_lane(), wid = wave_id, tid = wid * 64 + lane, wr = wid >> 2, wc = wid & 3, fr = lane & 15, fq = lane >> 4;
    const int K = g.K, nt = K / BK;
    unsigned voffA[2], voffB[2];
#pragma unroll
    for (int i = 0; i < 2; ++i) { int R, C; stage_rc(tid * 16 + i * 8192, R, C); const int Rb = Epi::PERM ? ((R & ~31) + perm32(R & 31)) : R;
        voffA[i] = AG32 ? (unsigned)((C >> 5) * BM * 32 + R * 32 + (C & 31)) * 2u : (unsigned)(R * K + C) * 2u; voffB[i] = (unsigned)(Rb * K + C) * 2u; }
    const size_t kstep = (size_t)(BK * 2);
    const size_t hstep = (size_t)HALF * K * 2;
    const size_t tstep = 2 * hstep;
    const size_t kstepA = AG32 ? (size_t)2 * BM * 32 * 2 : kstep, hstepA = AG32 ? (size_t)HALF * 32 * 2 : hstep, tstepA = tstep;
    const unsigned ldsw = (unsigned)wid * 1024u;
    const unsigned ldsd = (unsigned)__builtin_amdgcn_readfirstlane((int)((unsigned)(uintptr_t)lds + ldsw));
    const int aoff = lds_byte(wr * 64 + fr, fq * 8), boff = lds_byte(wc * 32 + fr, fq * 8);
#define PG8_SA(b, h) (((b) * 2 + (h)) * HTB)
#define PG8_SB(b, h) ((4 + (b) * 2 + (h)) * HTB)
#ifdef STAGE_BUILTIN
#define PG8_STAGE(bufoff, gbase, voff) do { if (ABL != 1) _Pragma("unroll") for (int _i = 0; _i < 2; ++_i) \
        __builtin_amdgcn_global_load_lds((const unsigned*)((const char*)(gbase) + (voff)[_i]), (PG8_LAS unsigned*)(lds + (bufoff) + ldsw + _i * 8192), 16, 0, 0); } while (0)
#else
#define PG8_STAGE(bufoff, gbase, voff) do { if (ABL != 1) { glds16s<(bufoff)>((const void*)(gbase), (voff)[0], ldsd); glds16s<(bufoff) + 8192>((const void*)(gbase), (voff)[1], ldsd); } } while (0)
#endif
#define PG8_LDA(dst, b, h) do { if (ABL != 2) _Pragma("unroll") for (int m = 0; m < 4; ++m) _Pragma("unroll") for (int k = 0; k < 2; ++k) dst[m][k] = *(const PG8_LAS bf16x8*)(lds + PG8_SA(b, h) + aoff + m * 2048 + k * 1024); } while (0)
#define PG8_LDB(dst, b, h) do { if (ABL != 2) _Pragma("unroll") for (int n = 0; n < 2; ++n) _Pragma("unroll") for (int k = 0; k < 2; ++k) dst[n][k] = *(const PG8_LAS bf16x8*)(lds + PG8_SB(b, h) + boff + n * 2048 + k * 1024); } while (0)
#ifdef GEMM_STATIC_PRIO
#define PG8_PRIO_UP() do {} while (0)
#define PG8_PRIO_DN() do {} while (0)
#else
#define PG8_PRIO_UP() __builtin_amdgcn_s_setprio(1)
#define PG8_PRIO_DN() __builtin_amdgcn_s_setprio(0)
#endif
#define PG8_MMA(ai, bj, At, Bt) do { PG8_PRIO_UP(); _Pragma("unroll") for (int m = 0; m < 4; ++m) _Pragma("unroll") for (int n = 0; n < 2; ++n) _Pragma("unroll") for (int k = 0; k < 2; ++k) \
        acc[ai][bj][m][n] = mma16(Bt[n][k], At[m][k], acc[ai][bj][m][n]); PG8_PRIO_DN(); } while (0)
#define PG8_MMAZ(ai, bj, At, Bt) do { PG8_PRIO_UP(); _Pragma("unroll") for (int m = 0; m < 4; ++m) _Pragma("unroll") for (int n = 0; n < 2; ++n) { \
        acc[ai][bj][m][n] = mma16(Bt[n][0], At[m][0], (acc_t){0, 0, 0, 0}); acc[ai][bj][m][n] = mma16(Bt[n][1], At[m][1], acc[ai][bj][m][n]); } PG8_PRIO_DN(); } while (0)
#define PG8_WAIT_V(n) asm volatile("s_waitcnt vmcnt(" #n ")" ::: "memory")
#define PG8_WAIT_L(n) asm volatile("s_waitcnt lgkmcnt(" #n ")" ::: "memory")
#define PG8_BAR do { if (ABL != 3) __builtin_amdgcn_s_barrier(); } while (0)
#define PG8_SCHED __builtin_amdgcn_sched_barrier(0)
#ifdef GEMM_STATIC_PRIO
    if (wr == 1) __builtin_amdgcn_s_setprio(1);
#endif
    constexpr bool PEEL = SP2 && !ZeroByMov<Epi>::v;
    Unit cur, nxt; int ui = 0;
    if (!S.next(0, cur)) return;
#define PG8_SIDE(unit, par) do { if constexpr (Epi::SIDE) { int _l = ::mk_lane(); asm volatile("" : "+v"(_l)); \
        __builtin_amdgcn_global_load_lds((const unsigned*)(Epi::side_src(unit, wid) + _l * 4), (PG8_LAS unsigned*)(lds + SIDE_REL + (par) * 2048 + wid * 256), 4, 0, 0); } } while (0)
    PG8_SIDE(cur, 0);
    typedef typename AccOf<Epi>::type acc_t;
    acc_t acc[2][2][4][2];
    if constexpr (!PEEL) {
#pragma unroll
    for (int a = 0; a < 2; ++a)
#pragma unroll
        for (int b = 0; b < 2; ++b)
#pragma unroll
            for (int m = 0; m < 4; ++m)
#pragma unroll
                for (int n = 0; n < 2; ++n) acc[a][b][m][n] = (acc_t){0, 0, 0, 0};
    }
    bf16x8 At[4][2], B0[2][2], B1[2][2];
    if (ABL == 2) { _Pragma("unroll") for (int m = 0; m < 4; ++m) _Pragma("unroll") for (int k = 0; k < 2; ++k) { At[m][k] = (bf16x8){(short)(0x3f80 + lane), 1, 2, 3, 4, 5, 6, (short)(0x3c00 + m)}; asm volatile("" : "+v"(At[m][k])); }
        _Pragma("unroll") for (int n = 0; n < 2; ++n) _Pragma("unroll") for (int k = 0; k < 2; ++k) { B0[n][k] = (bf16x8){(short)(0x3e80 + lane), 7, 6, 5, 4, 3, 2, 1}; B1[n][k] = B0[n][k]; asm volatile("" : "+v"(B0[n][k]), "+v"(B1[n][k])); } }
    const char* cA = (const char*)g.A + (size_t)cur.pm * tstepA; const char* cB = (const char*)g.Bt + (size_t)cur.pn * tstep;
    S.a_ready(cur);
    if constexpr (SP2) {
        PG8_STAGE(PG8_SB(0, 0), cB, voffB); PG8_STAGE(PG8_SB(0, 1), cB + hstep, voffB); PG8_STAGE(PG8_SA(0, 0), cA, voffA); PG8_STAGE(PG8_SA(0, 1), cA + hstepA, voffA);
        if (wr == 1) PG8_BAR;
        PG8_WAIT_V(2); PG8_BAR;
        PG8_STAGE(PG8_SB(1, 0), cB + kstep, voffB); PG8_STAGE(PG8_SA(1, 0), cA + kstepA, voffA); PG8_STAGE(PG8_SB(1, 1), cB + hstep + kstep, voffB);
        PG8_WAIT_V(6); PG8_BAR;
    } else {
        PG8_STAGE(PG8_SB(0, 0), cB, voffB); PG8_STAGE(PG8_SA(0, 0), cA, voffA); PG8_STAGE(PG8_SB(0, 1), cB + hstep, voffB); PG8_STAGE(PG8_SA(0, 1), cA + hstepA, voffA);
        if (wr == 1) PG8_BAR;
        PG8_WAIT_V(4); PG8_BAR;
        PG8_STAGE(PG8_SB(1, 0), cB + kstep, voffB); PG8_STAGE(PG8_SA(1, 0), cA + kstepA, voffA); PG8_STAGE(PG8_SB(1, 1), cB + hstep + kstep, voffB);
        PG8_WAIT_V(6); PG8_BAR;
    }
    for (;;) {
        const bool has_next = S.next(ui + 1, nxt);
        const char* nA = has_next ? (const char*)g.A + (size_t)nxt.pm * tstepA : cA; const char* nB = has_next ? (const char*)g.Bt + (size_t)nxt.pn * tstep : cB;
        if constexpr (SP2) {
          if constexpr (PEEL) { const int t = 0;
            const bool last = (t == nt - 2);
            const char* a1 = cA + (size_t)(t + 1) * kstepA;
            const char* a2 = last ? nA : cA + (size_t)(t + 2) * kstepA; const char* b2 = last ? nB : cB + (size_t)(t + 2) * kstep;
            const char* a3 = a2 + kstepA; const char* b3 = b2 + kstep;
            if (last && has_next) S.a_ready(nxt);
            PG8_LDB(B0, 0, 0); PG8_LDB(B1, 0, 1); PG8_SCHED; PG8_LDA(At, 0, 0); PG8_STAGE(PG8_SA(1, 1), a1 + hstepA, voffA);
            PG8_WAIT_V(8); PG8_WAIT_L(0); PG8_BAR; PG8_MMAZ(0, 0, At, B0); PG8_MMAZ(0, 1, At, B1); PG8_BAR; PG8_SCHED;
            PG8_LDA(At, 0, 1); PG8_STAGE(PG8_SB(0, 0), b2, voffB); PG8_STAGE(PG8_SB(0, 1), b2 + hstep, voffB); PG8_STAGE(PG8_SA(0, 0), a2, voffA);
            PG8_WAIT_V(8); PG8_WAIT_L(0); PG8_BAR; PG8_MMAZ(1, 0, At, B0); PG8_MMAZ(1, 1, At, B1); PG8_BAR; PG8_SCHED;
            PG8_LDB(B0, 1, 0); PG8_LDB(B1, 1, 1); PG8_SCHED; PG8_LDA(At, 1, 0); PG8_STAGE(PG8_SA(0, 1), a2 + hstepA, voffA);
            PG8_WAIT_V(8); PG8_WAIT_L(0); PG8_BAR; PG8_MMA(0, 0, At, B0); PG8_MMA(0, 1, At, B1); PG8_BAR; PG8_SCHED;
            PG8_LDA(At, 1, 1); PG8_STAGE(PG8_SB(1, 0), b3, voffB); PG8_STAGE(PG8_SB(1, 1), b3 + hstep, voffB); PG8_STAGE(PG8_SA(1, 0), a3, voffA);
            PG8_WAIT_V(8); PG8_WAIT_L(0); PG8_BAR; PG8_MMA(1, 0, At, B0); PG8_MMA(1, 1, At, B1); PG8_BAR; PG8_SCHED;
          }
          for (int t = PEEL ? 2 : 0; t < nt; t += 2) {
            const bool last = (t == nt - 2);
            const char* a1 = cA + (size_t)(t + 1) * kstepA;
            const char* a2 = last ? nA : cA + (size_t)(t + 2) * kstepA; const char* b2 = last ? nB : cB + (size_t)(t + 2) * kstep;
            const char* a3 = a2 + kstepA; const char* b3 = b2 + kstep;
            if (last && has_next) S.a_ready(nxt);
            PG8_LDB(B0, 0, 0); PG8_LDB(B1, 0, 1); PG8_SCHED; PG8_LDA(At, 0, 0); PG8_STAGE(PG8_SA(1, 1), a1 + hstepA, voffA);
            PG8_WAIT_V(8); PG8_WAIT_L(0); PG8_BAR; PG8_MMA(0, 0, At, B0); PG8_MMA(0, 1, At, B1); PG8_BAR; PG8_SCHED;
            PG8_LDA(At, 0, 1); PG8_STAGE(PG8_SB(0, 0), b2, voffB); PG8_STAGE(PG8_SB(0, 1), b2 + hstep, voffB); PG8_STAGE(PG8_SA(0, 0), a2, voffA);
            PG8_WAIT_V(8); PG8_WAIT_L(0); PG8_BAR; PG8_MMA(1, 0, At, B0); PG8_MMA(1, 1, At, B1); PG8_BAR; PG8_SCHED;
            PG8_LDB(B0, 1, 0); PG8_LDB(B1, 1, 1); PG8_SCHED; PG8_LDA(At, 1, 0); PG8_STAGE(PG8_SA(0, 1), a2 + hstepA, voffA);
            PG8_WAIT_V(8); PG8_WAIT_L(0); PG8_BAR; PG8_MMA(0, 0, At, B0); PG8_MMA(0, 1, At, B1); PG8_BAR; PG8_SCHED;
            PG8_LDA(At, 1, 1); PG8_STAGE(PG8_SB(1, 0), b3, voffB); PG8_STAGE(PG8_SB(1, 1), b3 + hstep, voffB); PG8_STAGE(PG8_SA(1, 0), a3, voffA);
            PG8_WAIT_V(8); PG8_WAIT_L(0); PG8_BAR; PG8_MMA(1, 0, At, B0); PG8_MMA(1, 1, At, B1); PG8_BAR; PG8_SCHED;
          }
        } else {
        for (int t = 0; t < nt; t += 2) {
            const bool last = (t == nt - 2);
            const char* a1 = cA + (size_t)(t + 1) * kstepA;
            const char* a2 = last ? nA : cA + (size_t)(t + 2) * kstepA; const char* b2 = last ? nB : cB + (size_t)(t + 2) * kstep;
            const char* a3 = a2 + kstepA; const char* b3 = b2 + kstep;
            if (last && has_next) S.a_ready(nxt);
            PG8_LDB(B0, 0, 0); PG8_SCHED; PG8_LDA(At, 0, 0); PG8_STAGE(PG8_SA(1, 1), a1 + hstepA, voffA);
            PG8_WAIT_L(8); PG8_BAR; PG8_WAIT_L(0); PG8_MMA(0, 0, At, B0); PG8_BAR; PG8_SCHED;
            PG8_LDB(B1, 0, 1); PG8_STAGE(PG8_SB(0, 0), b2, voffB);
            PG8_BAR; PG8_WAIT_L(0); PG8_MMA(0, 1, At, B1); PG8_BAR;
            PG8_LDA(At, 0, 1); PG8_STAGE(PG8_SA(0, 0), a2, voffA);
            PG8_BAR; PG8_WAIT_L(0); PG8_MMA(1, 0, At, B0); PG8_BAR; PG8_SCHED;
            PG8_STAGE(PG8_SB(0, 1), b2 + hstep, voffB);
            PG8_WAIT_V(6); PG8_BAR; PG8_MMA(1, 1, At, B1); PG8_BAR;
            PG8_LDB(B0, 1, 0); PG8_SCHED; PG8_LDA(At, 1, 0); PG8_STAGE(PG8_SA(0, 1), a2 + hstepA, voffA);
            PG8_WAIT_L(8); PG8_BAR; PG8_WAIT_L(0); PG8_MMA(0, 0, At, B0); PG8_BAR; PG8_SCHED;
            PG8_LDB(B1, 1, 1); PG8_STAGE(PG8_SB(1, 0), b3, voffB);
            PG8_BAR; PG8_WAIT_L(0); PG8_MMA(0, 1, At, B1); PG8_BAR;
            PG8_LDA(At, 1, 1); PG8_STAGE(PG8_SA(1, 0), a3, voffA);
            PG8_BAR; PG8_WAIT_L(0); PG8_MMA(1, 0, At, B0); PG8_BAR; PG8_SCHED;
            PG8_STAGE(PG8_SB(1, 1), b3 + hstep, voffB);
            PG8_WAIT_V(6); PG8_BAR; PG8_MMA(1, 1, At, B1); PG8_BAR;
        }
        }
        if constexpr (ALIGN_EPI) { if (wr == 0) PG8_BAR; }
        if constexpr (!Epi::AFTER_DRAIN) { int l2 = ::mk_lane(); asm volatile("" : "+v"(l2)); if constexpr (Epi::SIDE) E(acc, cur, wr, wc, l2 & 15, l2 >> 4, lds + SIDE_REL + (ui & 1) * 2048); else E(acc, cur, wr, wc, l2 & 15, l2 >> 4); S.done(cur); }
        if (!has_next) break;
        if constexpr (!PEEL) {
#pragma unroll
        for (int a = 0; a < 2; ++a)
#pragma unroll
            for (int b = 0; b < 2; ++b)
#pragma unroll
                for (int m = 0; m < 4; ++m)
#pragma unroll
                    for (int n = 0; n < 2; ++n) acc[a][b][m][n] = (acc_t){0, 0, 0, 0};
        }
        cur = nxt; cA = nA; cB = nB; ++ui;
        PG8_SIDE(cur, ui & 1);
        if constexpr (ALIGN_EPI) { if (wr == 1) PG8_BAR; }
    }
#ifdef GEMM_STATIC_PRIO
    __builtin_amdgcn_s_setprio(0);
#endif
    PG8_WAIT_V(0);
    if constexpr (!ALIGN_EPI) { if (wr == 0) PG8_BAR; }
    PG8_BAR;
    if constexpr (Epi::AFTER_DRAIN) { E.fused(acc, cur, wr, wc, fr, fq, lds, wid, lane); S.done(cur); }
#undef PG8_SIDE
#undef PG8_SA
#undef PG8_SB
#undef PG8_STAGE
#undef PG8_LDA
#undef PG8_LDB
#undef PG8_MMA
#undef PG8_PRIO_UP
#undef PG8_PRIO_DN
#undef PG8_MMAZ
#undef PG8_WAIT_V
#undef PG8_WAIT_L
#undef PG8_BAR
#undef PG8_SCHED
}
}
namespace attn128 {
using bf16=unsigned short;
using bf16x8=__attribute__((ext_vector_type(8)))short;
using s16x4=__attribute__((ext_vector_type(4)))short;
using f32x16=__attribute__((ext_vector_type(16)))float;
using u32x4=__attribute__((ext_vector_type(4)))unsigned;
constexpr int BATCH=8,SEQ=4096,D=64,DV=128,DM=512,DMA=512,DMO=1024;
constexpr int NW=8,QBLK=32,QB=QBLK*NW,KVBLK=64,NQB=SEQ/QB;
constexpr int NSLOT=3,SLOTB=8192;
constexpr int LDS_K=0, LDS_V=NSLOT*SLOTB, LDS_WS=LDS_V+NSLOT*2*SLOTB, LDS_BYTES=LDS_WS+NW*64*4, LDS_OST=0;
static_assert(NW*8192<=LDS_WS,"O stage must stay below the f32 scratch");
__device__ __forceinline__ int crow(int r,int hi){return (r&3)+8*(r>>2)+4*hi;}
#define SBAR() __builtin_amdgcn_sched_barrier(0)
__device__ __forceinline__ void cmask(f32x16&p0,f32x16&p1,int jb,int qrel,int hi){
  const float NEG=-INFINITY; int kb=64*jb+4*hi;
  #pragma unroll
  for(int r=0;r<16;++r){int kv=kb+(r&3)+8*(r>>2); if(kv>qrel)p0[r]=NEG; if(kv+32>qrel)p1[r]=NEG;}
}
__device__ __forceinline__ void glds16(const void*sbase,unsigned voff,unsigned lds_dst){unsigned keep;
  asm volatile("s_nop 4\n\ts_mov_b32 %0, m0\n\ts_mov_b32 m0, %3\n\ts_nop 0\n\tglobal_load_lds_dwordx4 %1, %2\n\ts_mov_b32 m0, %0":"=&s"(keep):"v"(voff),"s"(sbase),"s"(lds_dst):"memory");}
typedef float f32x2_t __attribute__((ext_vector_type(2))); typedef __bf16 bf16x2_t __attribute__((ext_vector_type(2)));
__device__ __forceinline__ unsigned cvtpk_s(float lo,float hi){f32x2_t v={lo,hi};bf16x2_t b=__builtin_convertvector(v,bf16x2_t);return __builtin_bit_cast(unsigned,b);}
#define WAIT_BAR(N) asm volatile("s_waitcnt vmcnt(" #N ") lgkmcnt(0)\n\ts_barrier":::"memory")
typedef __attribute__((address_space(3))) const char* lds_cptr;
typedef short v4i16_t __attribute__((ext_vector_type(4)));
__device__ __forceinline__ void kload2(bf16x8*kf,lds_cptr kp,int j){ kf[2*j]=*(const __attribute__((address_space(3))) bf16x8*)(kp+j*2048); kf[2*j+1]=*(const __attribute__((address_space(3))) bf16x8*)(kp+j*2048+512); }
__device__ __forceinline__ s16x4 vtr(lds_cptr p){ return __builtin_bit_cast(s16x4,__builtin_amdgcn_ds_read_tr16_b64_v4i16((__attribute__((address_space(3))) v4i16_t*)p)); }
#define MX3(a,b,c) __builtin_fmaxf(__builtin_fmaxf((a),(b)),(c))
__device__ __forceinline__ float rowmax(const f32x16&p0,const f32x16&p1){
  float a=MX3(p0[0],p0[1],p1[0]),b=MX3(p0[2],p0[3],p1[1]);a=MX3(a,p1[2],p1[3]);
  #pragma unroll
  for(int r=4;r<16;r+=4){a=MX3(a,p0[r],p0[r+1]);b=MX3(b,p0[r+2],p0[r+3]);a=MX3(a,p1[r],p1[r+1]);b=MX3(b,p1[r+2],p1[r+3]);}
  float m=__builtin_fmaxf(a,b);
  auto rr=__builtin_amdgcn_permlane32_swap(__float_as_uint(m),__float_as_uint(m),false,false);
  return __builtin_fmaxf(__uint_as_float(rr[0]),__uint_as_float(rr[1]));
}
#define MFMA32(a,b,c) __builtin_amdgcn_mfma_f32_32x32x16_bf16(a,b,c,0,0,0)

struct ConvArgs { const bf16* B; const bf16* C; const bf16* U; const float* w; const float* g; };
template<int THRL,bool COMBINE> __device__ __forceinline__ void attn_unit(int b,int qcol,int vcol,int ocol,int qb,const bf16*Q,const bf16*__restrict__ K,const bf16*__restrict__ V,bf16*O,bf16*MIXO,const float*subln_g,const float lamv,const ConvArgs&CV,const int conv_r0,char*shm,const int wave_id){
  int lane_=::mk_lane(); asm volatile("":"+v"(lane_)); const int lane=lane_,r32=lane&31,hi=lane>>5; const int wid=wave_id;
  const long rowbase=(long)b*SEQ; const int q0=qb*QB;
  const bf16*Qw=Q+(rowbase+q0+wid*QBLK)*DM+qcol;
  const bf16*Kh=K+rowbase*DM+qcol,*Vh=V+rowbase*DM+vcol;
  const unsigned lds0=(unsigned)(uintptr_t)shm;
  float*wsf=(float*)(shm+LDS_WS)+wid*64;
  const unsigned koff=(unsigned)(lane*DM+wid*8)*2u;
  const unsigned voff=(unsigned)((16*(wid&3)+(lane>>2))*DM+(wid>>2)*32+(lane&3)*8)*2u;
  const unsigned kdst=lds0+LDS_K+wid*1024, vdst=lds0+LDS_V+wid*1024;
  #define DMA_K(t,slot) glds16(Kh+(long)(t)*KVBLK*DM,koff,(unsigned)__builtin_amdgcn_readfirstlane(kdst+(slot)))
  #define DMA_V(t,slot) do{ glds16(Vh+(long)(t)*KVBLK*DM,voff,(unsigned)__builtin_amdgcn_readfirstlane(vdst+2*(slot))); glds16(Vh+(long)(t)*KVBLK*DM+64,voff,(unsigned)__builtin_amdgcn_readfirstlane(vdst+2*(slot)+8192)); }while(0)
  bf16x8 kf[8];
  const lds_cptr shm3=(lds_cptr)shm; const lds_cptr kp0=shm3+LDS_K+hi*1024+r32*16; const lds_cptr vp0=shm3+LDS_V+((lane>>4)&1)*32+(lane&3)*8+(4*hi+((lane&15)>>2))*64;
  const int NT=(q0+QB)/KVBLK;
  DMA_K(0,0);DMA_V(0,0);DMA_K(1,SLOTB);
  bf16x8 qr[4];
  #pragma unroll
  for(int d0=0;d0<4;++d0)qr[d0]=*reinterpret_cast<const bf16x8*>(&Qw[(long)r32*DM+d0*16+hi*8]);
  float mhat=0.f,l_reg=0.f;f32x16 o[4];o[0]=f32x16{};o[1]=f32x16{};o[2]=f32x16{};o[3]=f32x16{};
  const int qrel=wid*QBLK+r32;
  bool resc=false;
  #define RESC() do{ if(resc){ asm volatile("s_waitcnt lgkmcnt(0)":::"memory"); \
      _Pragma("unroll") for(int r=0;r<16;++r){ const float f_=wsf[crow(r,hi)]; o[0][r]*=f_; o[1][r]*=f_; o[2][r]*=f_; o[3][r]*=f_; } } }while(0)
  f32x16 c0,c1; s16x4 vlo[8],vhi[8]; u32x4 pp0,pp1,pp2,pp3,pc0,pc1,pc2,pc3;
  int sl_prev=0,sl_cur=0,sl_next=SLOTB;
  #define ROT() do{sl_prev=sl_cur;sl_cur=sl_next;sl_next=(sl_next==(NSLOT-1)*SLOTB)?0:sl_next+SLOTB;}while(0)
  #define EX(v) __builtin_amdgcn_exp2f(v)
  #define PIN(x) asm volatile("":"+v"(x))
  #define FRAG(j) ((((j)&3)<<2)|((j)>>2))
  #define VRDS(s,f) do{ vlo[s]=vtr(vp_+(((f)>>2)*4096+((f)&3)*1024)); vhi[s]=vtr(vp_+(((f)>>2)*4096+((f)&3)*1024+512)); }while(0)
  #define VFS(s) (bf16x8){vlo[s][0],vlo[s][1],vlo[s][2],vlo[s][3],vhi[s][0],vhi[s][1],vhi[s][2],vhi[s][3]}
  #define SM2N(PC,W,X,B) do{ const float a_=EX(X[B]+nmh), b_=EX(X[(B)+1]+nmh); sacc+=a_; sacc+=b_; PC[W]=cvtpk_s(a_,b_); }while(0)
#ifdef NEGM_MFMA
  #define SM2(PC,W,X,B) do{ const float a_=EX(X[B]), b_=EX(X[(B)+1]); sacc+=a_; sacc+=b_; PC[W]=cvtpk_s(a_,b_); }while(0)
  #define CINIT() __builtin_amdgcn_mfma_f32_32x32x2f32(one_,nmb,f32x16{},0,0,0)
#else
  #define SM2(PC,W,X,B) SM2N(PC,W,X,B)
  #define CINIT() f32x16{}
#endif
  DMA_K(2,2*SLOTB);
  WAIT_BAR(4);
  { _Pragma("unroll") for(int j=0;j<4;++j)kload2(kf,kp0,j);
    c0=MFMA32(kf[0],qr[0],f32x16{}); c1=MFMA32(kf[1],qr[0],f32x16{}); c0=MFMA32(kf[2],qr[1],c0); c1=MFMA32(kf[3],qr[1],c1);
    c0=MFMA32(kf[4],qr[2],c0); c1=MFMA32(kf[5],qr[2],c1); c0=MFMA32(kf[6],qr[3],c0); c1=MFMA32(kf[7],qr[3],c1);
    if(NT==4)cmask(c0,c1,0,qrel,hi);
    mhat=rowmax(c0,c1); const float nmh=-mhat; float sacc=0.f;
    SM2N(pp0,0,c0,0);SM2N(pp0,1,c0,2);SM2N(pp0,2,c0,4);SM2N(pp0,3,c0,6);SM2N(pp1,0,c0,8);SM2N(pp1,1,c0,10);SM2N(pp1,2,c0,12);SM2N(pp1,3,c0,14);
    SM2N(pp2,0,c1,0);SM2N(pp2,1,c1,2);SM2N(pp2,2,c1,4);SM2N(pp2,3,c1,6);SM2N(pp3,0,c1,8);SM2N(pp3,1,c1,10);SM2N(pp3,2,c1,12);SM2N(pp3,3,c1,14);
    l_reg=sacc; }
#ifdef NEGM_MFMA
  float nmb=-0.5f*mhat;
#endif
  WAIT_BAR(0);
  DMA_K(3,0);DMA_V(1,SLOTB);
  ROT();
  _Pragma("unroll") for(int j=0;j<4;++j)kload2(kf,kp0+sl_cur,j);
  WAIT_BAR(3);
  #define GAPB(J,PP,PC,W,X,B,GL) do{ o[(J)&3]=MFMA32(__builtin_bit_cast(bf16x8,PP),VFS((J)&7),o[(J)&3]); SM2(PC,W,X,B); PIN(sacc); PIN(PC); \
      if((J)<8){ VRDS((J)&7,FRAG(((J)&7)+8)); } if((GL)&&(J)>=3&&(J)<=6){ kload2(kf,kp0+sl_next,(J)-3); } SBAR(); }while(0)
#ifdef NEGM_MFMA
  #define RMREL(rm) (rm)
  #define MUPD(dl) do{ nmb-=0.5f*(dl); c0-=(dl); c1-=(dl); }while(0)
  #define NMH_DECL
  #define ONE_DECL float one_=1.0f; asm volatile("":"+v"(one_))
#else
  #define ONE_DECL
  #define RMREL(rm) ((rm)-mhat)
  #define MUPD(dl) do{ mhat+=(dl); }while(0)
  #define NMH_DECL const float nmh=-mhat
#endif
  #define STEPX(t,MASK,GK,GV,GL,PA0,PA1,PA2,PA3,PB0,PB1,PB2,PB3) do{ SBAR(); ONE_DECL; \
    const lds_cptr vp_=vp0+2*sl_prev; \
    VRDS(0,FRAG(0)); SBAR(); c0=MFMA32(kf[0],qr[0],CINIT()); SBAR(); \
    VRDS(1,FRAG(1)); SBAR(); c1=MFMA32(kf[1],qr[0],CINIT()); SBAR(); \
    VRDS(2,FRAG(2)); SBAR(); c0=MFMA32(kf[2],qr[1],c0); SBAR(); \
    VRDS(3,FRAG(3)); SBAR(); c1=MFMA32(kf[3],qr[1],c1); SBAR(); \
    VRDS(4,FRAG(4)); SBAR(); c0=MFMA32(kf[4],qr[2],c0); SBAR(); \
    VRDS(5,FRAG(5)); SBAR(); c1=MFMA32(kf[5],qr[2],c1); SBAR(); \
    VRDS(6,FRAG(6)); SBAR(); c0=MFMA32(kf[6],qr[3],c0); SBAR(); \
    VRDS(7,FRAG(7)); SBAR(); c1=MFMA32(kf[7],qr[3],c1); SBAR(); \
    if(GK){DMA_K((t)+3,sl_cur);} if(GV){DMA_V((t)+1,sl_next);} \
    if(MASK){ const int jb_=(t)-(NT-4); if(jb_>=0)cmask(c0,c1,jb_,qrel,hi); } \
    { const float rm=rowmax(c0,c1); resc=false; \
      if(__builtin_expect(__any(RMREL(rm)>(float)THRL),0)){ const float dl=__builtin_fmaxf(RMREL(rm),0.f); MUPD(dl); \
        const float f=__builtin_amdgcn_exp2f(-dl); l_reg*=f; { int l_=::mk_lane(); asm volatile("":"+v"(l_)); if(l_<32)wsf[l_]=f; } resc=true; } } \
    SBAR(); \
    { NMH_DECL; float sacc=0.f; \
      GAPB(0,PA0,PB0,0,c0,0,GL); GAPB(1,PA0,PB0,1,c0,2,GL); GAPB(2,PA0,PB0,2,c0,4,GL); GAPB(3,PA0,PB0,3,c0,6,GL); \
      GAPB(4,PA1,PB1,0,c0,8,GL); GAPB(5,PA1,PB1,1,c0,10,GL); GAPB(6,PA1,PB1,2,c0,12,GL); GAPB(7,PA1,PB1,3,c0,14,GL); \
      GAPB(8,PA2,PB2,0,c1,0,GL); GAPB(9,PA2,PB2,1,c1,2,GL); GAPB(10,PA2,PB2,2,c1,4,GL); GAPB(11,PA2,PB2,3,c1,6,GL); \
      GAPB(12,PA3,PB3,0,c1,8,GL); GAPB(13,PA3,PB3,1,c1,10,GL); GAPB(14,PA3,PB3,2,c1,12,GL); GAPB(15,PA3,PB3,3,c1,14,GL); \
      l_reg+=sacc; } \
    }while(0)
  #define STEP(t,MASK,GK,GV,GL) do{ STEPX(t,MASK,GK,GV,GL,pp0,pp1,pp2,pp3,pc0,pc1,pc2,pc3); pp0=pc0;pp1=pc1;pp2=pc2;pp3=pc3; }while(0)
  int t=1;
#ifndef NO_STEP_PAIR
#if defined(ATTN_PRIO) && ATTN_PRIO == 2
  for(;t+5<NT;t+=2){ if(wid>=4)__builtin_amdgcn_s_setprio(1); STEPX(t,false,true,true,true,pp0,pp1,pp2,pp3,pc0,pc1,pc2,pc3); WAIT_BAR(3); RESC(); ROT();
                     if(wid>=4)__builtin_amdgcn_s_setprio(0); STEPX(t+1,false,true,true,true,pc0,pc1,pc2,pc3,pp0,pp1,pp2,pp3); WAIT_BAR(3); RESC(); ROT(); }
#else
  for(;t+5<NT;t+=2){ STEPX(t,false,true,true,true,pp0,pp1,pp2,pp3,pc0,pc1,pc2,pc3); WAIT_BAR(3); RESC(); ROT();
                     STEPX(t+1,false,true,true,true,pc0,pc1,pc2,pc3,pp0,pp1,pp2,pp3); WAIT_BAR(3); RESC(); ROT(); }
#endif
#endif
  for(;t+4<NT;++t){ STEP(t,false,true,true,true); WAIT_BAR(3); RESC(); ROT(); }
  #define ENDW(tt) do{ if((tt)+3<NT){WAIT_BAR(3);} else if((tt)+2<NT){WAIT_BAR(2);} else {WAIT_BAR(0);} }while(0)
  const int lastlive=wid>>1;
  #define DEADSTEP(t,GK,GV,PVLIVE) do{ if(GK){DMA_K((t)+3,sl_cur);} if(GV){DMA_V((t)+1,sl_next);} resc=false; \
    if(PVLIVE){ const lds_cptr vp_=vp0+2*sl_prev; _Pragma("unroll") for(int j=0;j<16;++j){ const int s_=j&7; VRDS(s_,FRAG(j)); asm volatile("s_waitcnt lgkmcnt(0)":::"memory"); SBAR(); \
        o[j&3]=MFMA32(__builtin_bit_cast(bf16x8,(j>>2)==0?pp0:(j>>2)==1?pp1:(j>>2)==2?pp2:pp3),VFS(s_),o[j&3]); } } }while(0)
  const int tl=NT-4+lastlive;
  for(;t+1<NT&&t<=tl;++t){ STEP(t,true,(t+3<NT),(t+1<NT),((t+1<NT)&&(t<tl))); ENDW(t); RESC(); ROT(); }
  if(lastlive>=3){
    STEP(NT-1,true,false,false,false); RESC();
    const lds_cptr vp_=vp0+2*sl_cur;
    #pragma unroll
    for(int j=0;j<16;++j){ const int s=j&7; VRDS(s,FRAG(j)); asm volatile("s_waitcnt lgkmcnt(0)":::"memory"); SBAR();
      o[j&3]=MFMA32(__builtin_bit_cast(bf16x8,(j>>2)==0?pp0:(j>>2)==1?pp1:(j>>2)==2?pp2:pp3),VFS(s),o[j&3]); }
  } else {
    bool pv=true;
    for(;t<NT;++t){ DEADSTEP(t,(t+3<NT),(t+1<NT),pv); pv=false; if(t+1<NT){ ENDW(t); ROT(); } }
  }
  {auto rr=__builtin_amdgcn_permlane32_swap(__float_as_uint(l_reg),__float_as_uint(l_reg),false,false);l_reg=__uint_as_float(rr[0])+__uint_as_float(rr[1]);}
  { int le_=::mk_lane(); asm volatile("":"+v"(le_)); const int e32=le_&31,ehi=le_>>5;
    ::Conv4 cq; ::conv4_load(cq,CV.B,CV.C,CV.U,conv_r0,le_);
    if(ehi==0)wsf[32+e32]=l_reg;asm volatile("s_waitcnt lgkmcnt(0)":::"memory");
    float rli[16];
    #pragma unroll
    for(int r=0;r<16;++r)rli[r]=__builtin_amdgcn_rcpf(wsf[32+crow(r,ehi)]);
    asm volatile("s_waitcnt lgkmcnt(0)\n\ts_barrier":::"memory");
    bf16*Ow=O+(rowbase+q0+wid*QBLK)*DMA+ocol;
    u32x4 prev[8];
    if(COMBINE){
      #pragma unroll
      for(int i=0;i<8;++i){const int row=i*4+(le_>>4),ch=le_&15; prev[i]=*(const u32x4*)(Ow+(long)row*DMA+ch*8);} }
    bf16*stg=(bf16*)(shm+LDS_OST)+wid*4096;
    #pragma unroll
    for(int r=0;r<16;++r){const int orow=crow(r,ehi);
      #pragma unroll
      for(int d0=0;d0<4;++d0)stg[orow*128+d0*32+e32]=(bf16)::f2bf(o[d0][r]*rli[r]);}
    asm volatile("s_waitcnt lgkmcnt(0)":::"memory");
    if(!COMBINE){
      #pragma unroll
      for(int i=0;i<8;++i){const int row=i*4+(le_>>4),ch=le_&15; const u32x4 v=*(const u32x4*)(stg+row*128+ch*8); *(u32x4*)(Ow+(long)row*DMA+ch*8)=v;}
    } else {
      const int ch=le_&15; float sg[8];
      #pragma unroll
      for(int e=0;e<8;++e)sg[e]=subln_g[ch*8+e]*(1.0f-::LAMBDA_INIT);
      bf16*Mw=MIXO+(rowbase+q0+wid*QBLK)*DMO+ocol;
      #pragma unroll
      for(int i=0;i<8;++i){const int row=i*4+(le_>>4); const u32x4 v2=*(const u32x4*)(stg+row*128+ch*8); float a0[8],a1[8],oo[8];
        ::unpack8(prev[i],a0); ::unpack8(v2,a1); float ss=0.f;
        #pragma unroll
        for(int e=0;e<8;++e){oo[e]=a0[e]-lamv*a1[e]; ss+=oo[e]*oo[e];}
        ss+=__shfl_xor(ss,1); ss+=__shfl_xor(ss,2); ss+=__shfl_xor(ss,4); ss+=__shfl_xor(ss,8);
        const float ra=1.0f/sqrtf(ss*(1.f/128.f)+::SUBLN_EPS);
        #pragma unroll
        for(int e=0;e<8;++e)oo[e]=oo[e]*ra*sg[e];
        pg8::st16((void*)(Mw+(long)row*DMO+ch*8),::pack8(oo));} }
    ::conv4_finish(cq,MIXO,CV.w,CV.g,conv_r0,le_); }
  asm volatile("s_waitcnt lgkmcnt(0)\n\ts_barrier":::"memory");
  #undef DMA_K
  #undef DMA_V
  #undef RESC
  #undef ROT
  #undef EX
  #undef PIN
  #undef FRAG
  #undef VRDS
  #undef VFS
  #undef SM2
  #undef GAPB
  #undef STEP
  #undef STEPX
  #undef RMREL
  #undef MUPD
  #undef NMH_DECL
  #undef ONE_DECL
  #undef CINIT
  #undef SM2N
  #undef ENDW
  #undef DEADSTEP
}
constexpr int ATTN_LDS_BYTES=LDS_BYTES;
struct AttnTensors { const bf16* Q; const bf16* K; const bf16* V; bf16* AO; bf16* MIX; const float* subln_g; const float* lam; ConvArgs cv; };
struct AttnUnit { int b, h, c, qb; };
struct StaticOrder {
  int vcu;
  __device__ __forceinline__ explicit StaticOrder(int grid,int block):vcu((block%8)*(grid/8)+block/8){}
  __device__ __forceinline__ bool next(int i,AttnUnit&u)const{ if(i>=4)return false; const int s=vcu&7; u.b=vcu>>5; u.h=(vcu>>3)&3; u.c=i&1; u.qb=(i>>1)?15-s:s; return true; }
};
#ifndef ATTN_THRL
#define ATTN_THRL 8
#endif
template<class Sched,int THRL=ATTN_THRL> __device__ __forceinline__ void attn_phase(char*lds,const AttnTensors&T,const Sched&S,const int wave_id){
  AttnUnit u; const float lamv=*T.lam;
#if defined(ATTN_PRIO) && ATTN_PRIO == 3
  if(wave_id<4)__builtin_amdgcn_s_setprio(1);
#endif
#if defined(ATTN_PRIO) && ATTN_PRIO == 1
  if(wave_id>=4)__builtin_amdgcn_s_setprio(1);
#endif
  for(int i=0;S.next(i,u);++i){
    const int cr0=u.b*SEQ+(((S.vcu&31)*NW+wave_id)*4+i)*4;
    if(u.c==0) attn_unit<THRL,false>(u.b,(u.h*2)*64,u.h*128,u.h*128,u.qb,T.Q,T.K,T.V,T.AO,T.MIX,T.subln_g,lamv,T.cv,cr0,lds,wave_id);
    else       attn_unit<THRL,true >(u.b,(u.h*2+1)*64,u.h*128,u.h*128,u.qb,T.Q,T.K,T.V,T.AO,T.MIX,T.subln_g,lamv,T.cv,cr0,lds,wave_id); }
#ifdef ATTN_PRIO
  __builtin_amdgcn_s_setprio(0);
#endif
}
#undef SBAR
#undef WAIT_BAR
#undef MX3
#undef MFMA32
}
#define GAS __attribute__((address_space(1)))
#define LAS __attribute__((address_space(3)))
typedef GAS unsigned gu32;
typedef GAS unsigned long long gu64;
#define RLX_AGENT __ATOMIC_RELAXED, __HIP_MEMORY_SCOPE_AGENT
#define LDS_WAIT() asm volatile("s_waitcnt lgkmcnt(0)" ::: "memory")
#define VM_WAIT() asm volatile("s_waitcnt vmcnt(0)" ::: "memory")
__device__ __forceinline__ unsigned long long rt() { return __builtin_amdgcn_s_memrealtime(); }

#define XB_TMO      128
#define XB_XCNT(j)  (256  + 64 * (j))
#define XB_XSUB(j)  (1280 + 64 * (j))
#define XB_XGEN(j)  (2304 + 64 * (j))
#define XB_TOP      3328
#define XB_TOPGEN   3392
#define XCD_BAR_WORDS 3456
#define XB_SPIN_CAP (1u << 18)

__device__ __forceinline__ unsigned xb_ld(unsigned* p)              { return __hip_atomic_load(p, __ATOMIC_RELAXED, __HIP_MEMORY_SCOPE_AGENT); }
__device__ __forceinline__ unsigned xb_add(unsigned* p, unsigned v) { return __hip_atomic_fetch_add(p, v, __ATOMIC_RELAXED, __HIP_MEMORY_SCOPE_AGENT); }
__device__ __forceinline__ unsigned xb_xcc_id() { return (unsigned)__builtin_amdgcn_s_getreg((3 << 11) | 20) & 0xFu; }
#define XB_SPIN(cond, bar) do { unsigned _sp = 0; while (cond) { __builtin_amdgcn_s_sleep(1); \
    if ((++_sp & 255u) == 0u) { if (xb_ld(&(bar)[XB_TMO])) break; if (_sp > XB_SPIN_CAP) { atomicAdd(&(bar)[XB_TMO], 1u); break; } } } } while (0)

struct XcdBarrier {
    unsigned* bar; unsigned x;
    volatile LAS unsigned* st; int wave;
};

__device__ __forceinline__ XcdBarrier xcd_barrier_post(unsigned* bar, volatile LAS unsigned* st) {
    XcdBarrier b; b.bar = bar; b.x = xb_xcc_id(); b.st = st;
    if (threadIdx.x == 0) (void)xb_add(&bar[XB_XCNT(b.x)], 1u);
    return b;
}
__device__ __forceinline__ void xcd_barrier_complete(unsigned* bar, unsigned x, unsigned& nloc, unsigned& nx) {
    const unsigned G = gridDim.x * gridDim.y * gridDim.z;
    unsigned sum, cnt, mine, sp = 0u;
    for (;;) {
        sum = 0u; cnt = 0u; mine = 0u;
#pragma unroll
        for (unsigned j = 0; j < 16; ++j) { const unsigned c = xb_ld(&bar[XB_XCNT(j)]); sum += c; cnt += (c > 0u) ? 1u : 0u; mine = (j == x) ? c : mine; }
        if (sum == G) break;
        __builtin_amdgcn_s_sleep(1);
        if ((++sp & 255u) == 0u) { if (xb_ld(&bar[XB_TMO])) break; if (sp > XB_SPIN_CAP) { atomicAdd(&bar[XB_TMO], 1u); break; } }
    }
    nloc = mine > 0u ? mine : 1u; nx = cnt > 0u ? cnt : 1u;
}

__device__ __forceinline__ void xcd_barrier(const XcdBarrier& b) {
    asm volatile("s_waitcnt vmcnt(0)" ::: "memory");
    __syncthreads();
    if (b.wave == 0 && ::mk_lane() == 0) {
        unsigned* bar = b.bar;
        __builtin_amdgcn_s_waitcnt(0);
        unsigned nloc = b.st[0], nx = b.st[1];
        if (nloc == 0u) { xcd_barrier_complete(bar, b.x, nloc, nx); b.st[0] = nloc; b.st[1] = nx; }
        const unsigned old = xb_add(&bar[XB_XSUB(b.x)], 1u);
        const unsigned gen = old / nloc;
        if (old + 1u == (gen + 1u) * nloc) {
            __builtin_amdgcn_fence(__ATOMIC_RELEASE, "agent");
            asm volatile("s_waitcnt vmcnt(0)" ::: "memory");
            const unsigned og = xb_add(&bar[XB_TOP], 1u);
            const unsigned tg = og / nx;
            if (og + 1u == (tg + 1u) * nx) xb_add(&bar[XB_TOPGEN], 1u);
            else XB_SPIN(xb_ld(&bar[XB_TOPGEN]) == tg, bar);
            __builtin_amdgcn_fence(__ATOMIC_ACQUIRE, "agent");
            xb_add(&bar[XB_XGEN(b.x)], 1u);
            asm volatile("s_waitcnt vmcnt(0)" ::: "memory");
        } else {
            XB_SPIN(xb_ld(&bar[XB_XGEN(b.x)]) == gen, bar);
            __builtin_amdgcn_fence(__ATOMIC_ACQUIRE, "agent");
            asm volatile("s_waitcnt vmcnt(0)" ::: "memory");
        }
    }
    __syncthreads();
}
#ifndef RES_ALIGN
#define RES_ALIGN true
#endif
#ifndef UP_ALIGN
#define UP_ALIGN true
#endif
constexpr int NWAVES = 8;
constexpr int NPHASE = 13;
constexpr int CW_TMO = 0, CW_CODE = 1, CW_BAR = 4096;
static_assert((CW_BAR + XCD_BAR_WORDS) * 4 <= (int)CTL_ZERO_BYTES, "barrier words inside the memset region");
constexpr int RING_OFF = 0, RING_BYTES = 131072;
constexpr int LDSCTL_OFF = RING_BYTES, MISC_OFF = LDSCTL_OFF + 320;
constexpr int LDS_BYTES = 147456;
static_assert(MISC_OFF + 128 <= LDS_BYTES, "LDS map");

struct Frame {
    LAS unsigned char* lds;
    volatile LAS unsigned* MISC;
    gu32* ctl;
    int vcu, G, wave;
};
__device__ __forceinline__ int fresh_lane() { int l = mk_lane(); asm volatile("" : "+v"(l)); return l; }


__device__ __forceinline__ void fill_block_f4(LAS float* scr, const float* W, int ld, int k0, int n0, int lane) {
    const int c4 = 4 * (lane & 7), r0 = lane >> 3; f32x4 v[8];
#pragma unroll
    for (int j = 0; j < 8; ++j) v[j] = *(const f32x4*)(W + (size_t)(k0 + r0 + 8 * j) * ld + n0 + c4);
#pragma unroll
    for (int j = 0; j < 8; ++j) { LAS float* d = scr + (r0 + 8 * j) * 33 + c4; d[0] = v[j][0]; d[1] = v[j][1]; d[2] = v[j][2]; d[3] = v[j][3]; }
}
__device__ __forceinline__ void p0_transpose_item(const float* W, int K, int N, bf16* WT, int k0, int n0, int drow0, LAS float* scr, int lane) {
    fill_block_f4(scr, W, N, k0, n0, lane);
    LDS_WAIT(); asm volatile("" ::: "memory");
    const int c = lane & 7;
#pragma unroll
    for (int j = 0; j < 4; ++j) { const int n = (lane >> 3) + 8 * j; const LAS float* s = scr + (8 * c) * 33 + n;
        v4u o; o.x = pk2(s[0 * 33], s[1 * 33]); o.y = pk2(s[2 * 33], s[3 * 33]); o.z = pk2(s[4 * 33], s[5 * 33]); o.w = pk2(s[6 * 33], s[7 * 33]);
        *(GAS v4u*)(WT + (size_t)(drow0 + n) * K + k0 + 8 * c) = o; }
    LDS_WAIT(); asm volatile("" ::: "memory");
}
struct P0Ptrs { const float *c, *w_ada, *b_ada, *w_adaf, *b_adaf, *f1w1, *f1w3, *f1w2, *f2w1, *f2w3, *f2w2, *w_in, *w_out, *lq1, *lk1, *lq2, *lk2; unsigned char* ws; };
__device__ __forceinline__ void p0_prologue(Frame& F, const P0Ptrs& P) {
    const int f_lane = fresh_lane(), f_wave = F.wave, f_tid = f_wave * 64 + f_lane;
    LAS float* ca = (LAS float*)(F.lds + RING_OFF);
    LAS float* part = (LAS float*)(F.lds + RING_OFF + 32768);
    constexpr int NTASK_ADA = (NMOD + NMODF) / 64;
    for (int task = F.vcu; task < NTASK_ADA; task += F.G) {
        for (int i = f_tid; i < BATCH * D; i += NWAVES * 64) { const float cv = P.c[i]; ca[i] = cv / (1.0f + expf(-cv)); }
        __syncthreads();
        int j0 = task * 64; const float* W; int ld; const float* bias; float* dst; int ldd;
        if (j0 < NMOD) { W = P.w_ada + j0; ld = NMOD; bias = P.b_ada + j0; dst = (float*)(P.ws + WS_MOD) + j0; ldd = NMOD; }
        else { j0 -= NMOD; W = P.w_adaf + j0; ld = NMODF; bias = P.b_adaf + j0; dst = (float*)(P.ws + WS_MODF) + j0; ldd = NMODF; }
        float acc[BATCH];
#pragma unroll
        for (int b = 0; b < BATCH; ++b) acc[b] = 0.f;
        const int kb = f_wave * 128;
#pragma unroll 8
        for (int kk = 0; kk < 128; ++kk) { const float wv = W[(size_t)(kb + kk) * ld + f_lane];
#pragma unroll
            for (int b = 0; b < BATCH; ++b) acc[b] += ca[b * D + kb + kk] * wv; }
#pragma unroll
        for (int b = 0; b < BATCH; ++b) part[(f_wave * BATCH + b) * 64 + f_lane] = acc[b];
        __syncthreads();
        { const int b = f_tid >> 6, col = f_tid & 63; float s = 0.f;
#pragma unroll
          for (int w = 0; w < NWAVES; ++w) s += part[(w * BATCH + b) * 64 + col];
          dst[(size_t)b * ldd + col] = s + bias[col]; }
        __syncthreads();
    }
    if (blockIdx.x == gridDim.x - 1 && f_tid == 0) *(float*)(P.ws + WS_LAM) = lam_value(P.lq1, P.lk1, P.lq2, P.lk2);
    for (int e = F.vcu * (NWAVES * 64) + f_tid; e < SEQ * 32; e += F.G * NWAVES * 64) { const int t = e >> 5, dd = e & 31;
        const float inv = 1.0f / powf(10000.0f, (float)(2 * dd) / 64.0f); const float ang = (float)t * inv; float sn, cs; sincosf(ang, &sn, &cs);
        ((float*)(P.ws + WS_ROPE))[2 * e] = cs; ((float*)(P.ws + WS_ROPE))[2 * e + 1] = sn; }
    LAS float* scr = (LAS float*)(F.lds + RING_OFF + f_wave * 16384);
    const int gw = F.vcu * NWAVES + f_wave, NGW = F.G * NWAVES;
    constexpr int I_UP = (D / 64) * (FF / 32), I_DN = (FF / 64) * (D / 32), I_IN = (D / 64) * (NIN / 32), I_OUT = (D / 64) * (D / 32);
    constexpr int NITEMS = 4 * I_UP + 2 * I_DN + I_IN + I_OUT;
    for (int it = gw; it < NITEMS; it += NGW) {
        int r = it;
        if (r < 4 * I_UP) {
            const int which = r / I_UP; r -= which * I_UP; const int nblk = FF / 32, kbi = r / nblk, nb = r % nblk, n0 = 32 * nb;
            const float* W = which == 0 ? P.f1w1 : which == 1 ? P.f1w3 : which == 2 ? P.f2w1 : P.f2w3;
            const int c4 = 4 * (f_lane & 7), r0 = f_lane >> 3; f32x4 v[8];
#pragma unroll
            for (int j = 0; j < 8; ++j) v[j] = *(const f32x4*)(W + (size_t)(64 * kbi + r0 + 8 * j) * FF + n0 + c4);
            float mx[4];
#pragma unroll
            for (int e = 0; e < 4; ++e) { float m = 0.f;
#pragma unroll
                for (int j = 0; j < 8; ++j) m = fmaxf(m, fabsf(v[j][e]));
                m = fmaxf(m, __shfl_xor(m, 8)); m = fmaxf(m, __shfl_xor(m, 16)); m = fmaxf(m, __shfl_xor(m, 32)); mx[e] = m; }
            if (f_lane < 8) {
#pragma unroll
                for (int e = 0; e < 4; ++e) atomicMax((unsigned*)(P.ws + WS_CTL) + CW_CMAX + (which >> 1) * 2 * FF + 256 * (n0 >> 7) + 128 * (which & 1) + (n0 & 127) + c4 + e, __float_as_uint(mx[e])); }
            continue; }
        r -= 4 * I_UP;
        if (r < 2 * I_DN) { const int which = r / I_DN; r -= which * I_DN; const int nblk = D / 32, kbi = r / nblk, nb = r % nblk, n0 = 32 * nb;
            p0_transpose_item(which == 0 ? P.f1w2 : P.f2w2, FF, D, (bf16*)(P.ws + (which == 0 ? WS_W2A : WS_W2B)), 64 * kbi, n0, n0, scr, f_lane); continue; }
        r -= 2 * I_DN;
        if (r < I_IN) { const int nblk = NIN / 32, kbi = r / nblk, nb = r % nblk, n0 = 32 * nb;
            int drow0 = n0; if (n0 < 1024) { const int tile = n0 >> 8, within = n0 & 255, g = within >> 6, half = (within >> 5) & 1; drow0 = tile * 256 + half * 128 + g * 32; }
            p0_transpose_item(P.w_in, D, NIN, (bf16*)(P.ws + WS_WIN), 64 * kbi, n0, drow0, scr, f_lane); continue; }
        r -= I_IN;
        { const int nblk = D / 32, kbi = r / nblk, nb = r % nblk, n0 = 32 * nb; p0_transpose_item(P.w_out, D, D, (bf16*)(P.ws + WS_WOUT), 64 * kbi, n0, n0, scr, f_lane); }
    }
}
template <bool TOBF>
__device__ __forceinline__ void phase_norm(Frame& F, const float* xs, void* out, const float* g, const float* shbase, const float* scbase, int ldmod) {
    const int f_lane = fresh_lane(), f_wave = F.wave;
    const int gw = F.vcu * NWAVES + f_wave, NGW = F.G * NWAVES;
    for (int r0 = gw * 16; r0 < M; r0 += NGW * 16) { const int b = r0 / SEQ; norm_rows<TOBF>(xs, out, g, shbase + (size_t)b * ldmod, scbase + (size_t)b * ldmod, r0, 16, f_lane); }
}
__device__ __forceinline__ void phase_mix(Frame& F, const bf16* Bb, const bf16* Cb, const bf16* Ub, bf16* MIX, const float* conv_w, const float* conv_g) {
    const int f_lane = fresh_lane(), f_wave = F.wave;
    const int gw = F.vcu * NWAVES + f_wave, NGW = F.G * NWAVES;
    for (int r0 = gw * 16; r0 < M; r0 += NGW * 16) conv_rows(Bb, Cb, Ub, MIX, conv_w, conv_g, r0, 16, f_lane);
}

struct P1Ptrs { const float *f1w1, *f1w3, *f2w1, *f2w3; };
template <int NW_ = NWAVES>
__device__ __forceinline__ void phase_p1_extras(Frame& F, unsigned char* ws, const float* mod, const P1Ptrs& P, int wv) {
    const int f_lane = fresh_lane(), f_wave = F.wave;
    const int gw = F.vcu * NW_ + wv, NGW = F.G * NW_;
    for (int i = gw * 64 + f_lane; i < 3 * M; i += NGW * 64) ((float*)(ws + WS_RSS2))[i] = 0.f;
    constexpr int NT_IN = NIN / 4;
    for (int task = gw; task < NT_IN; task += NGW) {
        const int n0 = 4 * task;
        const bf16* Wt = (const bf16*)(ws + WS_WIN) + (size_t)n0 * D;
        const float* sh = mod + 3 * D;
        float* dst = (float*)(ws + WS_SHWIN) + n0; const int ldd = NIN;
        float w[4][16];
#pragma unroll
        for (int r = 0; r < 4; ++r)
#pragma unroll
            for (int j = 0; j < 2; ++j) { float f[8]; unpack8(*(const v4u*)(Wt + (size_t)r * D + 512 * j + 8 * f_lane), f);
#pragma unroll
                for (int e = 0; e < 8; ++e) w[r][8 * j + e] = f[e]; }
#pragma unroll 1
        for (int b = 0; b < BATCH; ++b) {
            float sv[16];
#pragma unroll
            for (int j = 0; j < 2; ++j) { const f32x4 a = *(const f32x4*)(sh + (size_t)b * NMOD + 512 * j + 8 * f_lane), c = *(const f32x4*)(sh + (size_t)b * NMOD + 512 * j + 8 * f_lane + 4);
                sv[8 * j + 0] = a.x; sv[8 * j + 1] = a.y; sv[8 * j + 2] = a.z; sv[8 * j + 3] = a.w; sv[8 * j + 4] = c.x; sv[8 * j + 5] = c.y; sv[8 * j + 6] = c.z; sv[8 * j + 7] = c.w; }
#pragma unroll
            for (int r = 0; r < 4; ++r) { float d = 0.f;
#pragma unroll
                for (int e = 0; e < 16; ++e) d += w[r][e] * sv[e];
                d = wave_sum(d); if (f_lane == 0) dst[(size_t)b * ldd + r] = d; }
        }
    }
    LAS float* scr = (LAS float*)(F.lds + RING_OFF + f_wave * 16384);
    constexpr int I_UP = (D / 64) * (FF / 32), NIT = 4 * I_UP;
    struct QItem { f32x4 v[8]; float cmax; };
    auto q_issue = [&](QItem& Q, int it) {
        const int which = it / I_UP, r = it - which * I_UP; const int nblk = FF / 32, kbi = r / nblk, nb = r % nblk, n0 = 32 * nb, k0 = 64 * kbi;
        const float* W = which == 0 ? P.f1w1 : which == 1 ? P.f1w3 : which == 2 ? P.f2w1 : P.f2w3;
        const int drow0 = 256 * (n0 >> 7) + 128 * (which & 1) + (n0 & 127);
        const int c4 = 4 * (f_lane & 7), r0 = f_lane >> 3;
#pragma unroll
        for (int j = 0; j < 8; ++j) Q.v[j] = *(const f32x4*)(W + (size_t)(k0 + r0 + 8 * j) * FF + n0 + c4);
        Q.cmax = __uint_as_float(atomicMax((unsigned*)(ws + WS_CTL) + CW_CMAX + (which >> 1) * 2 * FF + drow0 + (f_lane >> 1), 0u));
    };
    auto q_finish = [&](const QItem& Q, int it) {
        const int which = it / I_UP, r = it - which * I_UP; const int nblk = FF / 32, kbi = r / nblk, nb = r % nblk, n0 = 32 * nb, k0 = 64 * kbi;
        const int drow0 = 256 * (n0 >> 7) + 128 * (which & 1) + (n0 & 127);
        const int n = f_lane >> 1, half = f_lane & 1, c4 = 4 * (f_lane & 7), r0 = f_lane >> 3;
#pragma unroll
        for (int j = 0; j < 8; ++j) { LAS float* d = scr + (r0 + 8 * j) * 33 + c4; d[0] = Q.v[j][0]; d[1] = Q.v[j][1]; d[2] = Q.v[j][2]; d[3] = Q.v[j][3]; }
        LDS_WAIT(); asm volatile("" ::: "memory");
        const float cmax = Q.cmax, cscale = cmax > 0.f ? cmax * (1.0f / 127.0f) : 1.0f, inv = 1.0f / cscale;
        const LAS float* sp = scr + (32 * half) * 33 + n;
        v4u o0, o1;
        o0.x = q8pack(sp[0 * 33], sp[1 * 33], sp[2 * 33], sp[3 * 33], inv);     o0.y = q8pack(sp[4 * 33], sp[5 * 33], sp[6 * 33], sp[7 * 33], inv);
        o0.z = q8pack(sp[8 * 33], sp[9 * 33], sp[10 * 33], sp[11 * 33], inv);   o0.w = q8pack(sp[12 * 33], sp[13 * 33], sp[14 * 33], sp[15 * 33], inv);
        o1.x = q8pack(sp[16 * 33], sp[17 * 33], sp[18 * 33], sp[19 * 33], inv); o1.y = q8pack(sp[20 * 33], sp[21 * 33], sp[22 * 33], sp[23 * 33], inv);
        o1.z = q8pack(sp[24 * 33], sp[25 * 33], sp[26 * 33], sp[27 * 33], inv); o1.w = q8pack(sp[28 * 33], sp[29 * 33], sp[30 * 33], sp[31 * 33], inv);
        signed char* W8 = (signed char*)(ws + (which < 2 ? WS_W13A : WS_W13B)) + (size_t)(drow0 + n) * D + k0 + 32 * half;
        *(GAS v4u*)W8 = o0; *(GAS v4u*)(W8 + 16) = o1;
        if (kbi == 0 && half == 0) ((float*)(ws + WS_CS))[(which >> 1) * 2 * FF + drow0 + n] = cscale;
        LDS_WAIT(); asm volatile("" ::: "memory");
    };
    QItem qa, qb;
    if (gw < NIT) q_issue(qa, gw);
    for (int it = gw; it < NIT; it += 2 * NGW) {
        const int it1 = it + NGW, it2 = it + 2 * NGW;
        if (it1 < NIT) q_issue(qb, it1);
        q_finish(qa, it);
        if (it1 < NIT) { if (it2 < NIT) q_issue(qa, it2); q_finish(qb, it1); }
    }
}
template <int NW_ = NWAVES>
__device__ __forceinline__ void phase_norm_q8(Frame& F, const float* xs, signed char* H8, float* rs, const float* g, const float* shbase, const float* scbase, int wv) {
    const int f_lane = fresh_lane();
    constexpr int RPW = 16 * NWAVES / NW_;
    const int gw = F.vcu * NW_ + wv, NGW = F.G * NW_;
    for (int r0 = gw * RPW; r0 < M; r0 += NGW * RPW) { const int b = r0 / SEQ; norm_rows_q8(xs, H8, rs, g, shbase + (size_t)b * NMOD, scbase + (size_t)b * NMOD, r0, RPW, f_lane); }
}
__device__ __forceinline__ void phase_norm_q8_bf(Frame& F, const bf16* xs, const float* rss, signed char* H8, float* rs, const float* g, const float* shbase, const float* scbase) {
    const int f_lane = fresh_lane(), f_wave = F.wave;
    const int gw = F.vcu * NWAVES + f_wave, NGW = F.G * NWAVES;
    for (int r0 = gw * 16; r0 < M; r0 += NGW * 16) { const int b = r0 / SEQ; norm_rows_q8_bf(xs, rss, H8, rs, g, shbase + (size_t)b * NMOD, scbase + (size_t)b * NMOD, r0, 16, f_lane); }
}
__device__ __forceinline__ void phase_final(Frame& F, const bf16* xs, const float* rss, float* out, const float* g, const float* shbase, const float* scbase) {
    const int f_lane = fresh_lane(), f_wave = F.wave;
    const int gw = F.vcu * NWAVES + f_wave, NGW = F.G * NWAVES;
    for (int r0 = gw * 16; r0 < M; r0 += NGW * 16) { const int b = r0 / SEQ;
        f32x4 gm[4], sh[4];
#pragma unroll
        for (int j = 0; j < 4; ++j) { const int c = 256 * j + 4 * f_lane; gm[j] = *(const f32x4*)(g + c) * (*(const f32x4*)(scbase + (size_t)b * NMODF + c) + 1.0f); sh[j] = *(const f32x4*)(shbase + (size_t)b * NMODF + c); }
        v2u q[4], n[4]; float ssq = rss[r0], nss = 0.f;
#pragma unroll
        for (int j = 0; j < 4; ++j) q[j] = *(const v2u*)(xs + (size_t)r0 * D + 256 * j + 4 * f_lane);
        for (int r = r0; r < r0 + 16; ++r) {
            if (r + 1 < r0 + 16) { nss = rss[r + 1];
#pragma unroll
                for (int j = 0; j < 4; ++j) n[j] = *(const v2u*)(xs + (size_t)(r + 1) * D + 256 * j + 4 * f_lane); }
            const float rs = pg8::rs_of(ssq);
#pragma unroll
            for (int j = 0; j < 4; ++j) { const f32x4 v = (f32x4){bf2f(q[j].x & 0xffffu), bf2f(q[j].x >> 16), bf2f(q[j].y & 0xffffu), bf2f(q[j].y >> 16)};
                *(f32x4*)(out + (size_t)r * D + 256 * j + 4 * f_lane) = v * rs * gm[j] + sh[j]; }
#pragma unroll
            for (int j = 0; j < 4; ++j) q[j] = n[j];
            ssq = nss; }
    }
}

__device__ __forceinline__ bool phase_in(int k) { const pg8::kargs_ptr ka = pg8::kargs_fresh(); return ka->ph_lo <= k && k < ka->ph_hi; }
__device__ __forceinline__ bool phase_after(int k) { const pg8::kargs_ptr ka = pg8::kargs_fresh(); return ka->ph_lo <= k && k + 1 < ka->ph_hi; }
__global__ void __launch_bounds__(NWAVES * 64, 2) skel_fwd(Args args) {
    extern __shared__ __attribute__((aligned(16))) unsigned char lds[];
    Frame F;
    F.lds = (LAS unsigned char*)lds;
    F.MISC = (volatile LAS unsigned*)(F.lds + MISC_OFF);
    F.wave = __builtin_amdgcn_readfirstlane((int)threadIdx.x >> 6);
    F.G = gridDim.x; { const int bx = blockIdx.x; F.vcu = (F.G % 8 == 0) ? (bx % 8) * (F.G / 8) + bx / 8 : bx; }
    unsigned char* ws = args.ws;
    F.ctl = (gu32*)(ws + WS_CTL);
    for (int u = threadIdx.x; u < (LDS_BYTES - LDSCTL_OFF) / 4; u += NWAVES * 64) ((LAS unsigned*)(F.lds + LDSCTL_OFF))[u] = 0u;
    __syncthreads();
    XcdBarrier bar; bar.bar = (unsigned*)(F.ctl + CW_BAR); bar.x = 0; bar.st = nullptr; bar.wave = F.wave;
    if (args.use_bar) { bar = xcd_barrier_post((unsigned*)(F.ctl + CW_BAR), F.MISC + 8); bar.wave = F.wave; }
#ifndef BAR_REP
#define BAR_REP 1
#endif
#define GRID_BAR() do { if (args.use_bar) { for (int _r = 0; _r < BAR_REP; ++_r) xcd_barrier(bar); } } while (0)
#define IN(k) phase_in(k)
#define AFTER(k) do { if (phase_after(k)) GRID_BAR(); } while (0)
    if (IN(0)) { unsigned char* ws = pg8::kargs_fresh()->ws; const pg8::kargs_ptr ka = pg8::kargs_fresh();
            P0Ptrs P{ka->in[1], ka->in[2], ka->in[3], ka->in[4], ka->in[5], ka->in[10], ka->in[11], ka->in[12], ka->in[13], ka->in[14], ka->in[15], ka->in[16], ka->in[24], ka->in[17], ka->in[18], ka->in[19], ka->in[20], ws};
            p0_prologue(F, P); AFTER(0); }
    if (IN(1)) { unsigned char* ws = pg8::kargs_fresh()->ws; const pg8::kargs_ptr ka = pg8::kargs_fresh(); const float* mod = (const float*)(ws + WS_MOD);
#ifdef P1_SERIAL
            { P1Ptrs P1{ka->in[10], ka->in[11], ka->in[13], ka->in[14]}; phase_p1_extras<NWAVES>(F, ws, mod, P1, F.wave); }
            phase_norm_q8<NWAVES>(F, ka->in[0], (signed char*)(ws + WS_H), (float*)(ws + WS_RS1), ka->in[6], mod + 0 * D, mod + 1 * D, F.wave);
#else
            if (F.wave < 4) phase_norm_q8<4>(F, ka->in[0], (signed char*)(ws + WS_H), (float*)(ws + WS_RS1), ka->in[6], mod + 0 * D, mod + 1 * D, F.wave);
            else { P1Ptrs P1{ka->in[10], ka->in[11], ka->in[13], ka->in[14]}; phase_p1_extras<4>(F, ws, mod, P1, F.wave - 4); }
#endif
            AFTER(1); }
    if (IN(2)) { unsigned char* ws = pg8::kargs_fresh()->ws; pg8::Gemm g{(const bf16*)(ws + WS_H), (const bf16*)(ws + WS_W13A), M, 2 * FF, D / 2}; pg8::StaticOrder S; S.init(M, 2 * FF, F.G, (int)blockIdx.x); pg8::EpiSwiGLUq<0> E{};

            pg8::gemm_phase<pg8::EpiSwiGLUq<0>, pg8::StaticOrder, UP_ALIGN, true>(F.lds + RING_OFF, g, S, E, F.wave);
            AFTER(2); }
    if (IN(3)) { unsigned char* ws = pg8::kargs_fresh()->ws; pg8::Gemm g{(const bf16*)(ws + WS_G), (const bf16*)(ws + WS_W2A), M, D, FF}; pg8::StaticOrder S; S.init(M, D, F.G, (int)blockIdx.x); pg8::EpiResidN<0> E{};
            pg8::gemm_phase<pg8::EpiResidN<0>, pg8::StaticOrder, RES_ALIGN, true>(F.lds + RING_OFF, g, S, E, F.wave); AFTER(3); }
    if (IN(5)) { unsigned char* ws = pg8::kargs_fresh()->ws; pg8::Gemm g{(const bf16*)(ws + WS_H), (const bf16*)(ws + WS_WIN), M, NIN, D}; pg8::StaticOrder S; S.init(M, NIN, F.G, (int)blockIdx.x); pg8::EpiZ E{};
            pg8::gemm_phase<pg8::EpiZ, pg8::StaticOrder, true, true>(F.lds + RING_OFF, g, S, E, F.wave); AFTER(5); }
    if (IN(6)) { unsigned char* ws = pg8::kargs_fresh()->ws; const pg8::kargs_ptr ka = pg8::kargs_fresh(); const attn128::AttnTensors AT{(const bf16*)(ws + WS_Q), (const bf16*)(ws + WS_K), (const bf16*)(ws + WS_V), (bf16*)(ws + WS_AO), (bf16*)(ws + WS_MIX), ka->in[21], (const float*)(ws + WS_LAM), {(const bf16*)(ws + WS_B), (const bf16*)(ws + WS_C), (const bf16*)(ws + WS_U), ka->in[22], ka->in[23]}}; const attn128::StaticOrder S((int)F.G, (int)blockIdx.x);
            attn128::attn_phase<attn128::StaticOrder>((char*)lds + RING_OFF, AT, S, F.wave); AFTER(6); }
    if (IN(8)) { unsigned char* ws = pg8::kargs_fresh()->ws; pg8::Gemm g{(const bf16*)(ws + WS_MIX), (const bf16*)(ws + WS_WOUT), M, D, D}; pg8::StaticOrder S; S.init(M, D, F.G, (int)blockIdx.x); pg8::EpiResidN<1> E{};
            pg8::gemm_phase<pg8::EpiResidN<1>, pg8::StaticOrder, RES_ALIGN, true>(F.lds + RING_OFF, g, S, E, F.wave); AFTER(8); }
    if (IN(9)) { unsigned char* ws = pg8::kargs_fresh()->ws; const pg8::kargs_ptr ka = pg8::kargs_fresh(); const float* mod = (const float*)(ws + WS_MOD);
            phase_norm_q8_bf(F, (const bf16*)(ws + WS_XS2), (const float*)(ws + WS_RSS3), (signed char*)(ws + WS_H), (float*)(ws + WS_RS3), ka->in[8], mod + 6 * D, mod + 7 * D); AFTER(9); }
    if (IN(10)) { unsigned char* ws = pg8::kargs_fresh()->ws; pg8::Gemm g{(const bf16*)(ws + WS_H), (const bf16*)(ws + WS_W13B), M, 2 * FF, D / 2}; pg8::StaticOrder S; S.init(M, 2 * FF, F.G, (int)blockIdx.x); pg8::EpiSwiGLUq<1> E{};

            pg8::gemm_phase<pg8::EpiSwiGLUq<1>, pg8::StaticOrder, UP_ALIGN, true>(F.lds + RING_OFF, g, S, E, F.wave);
            AFTER(10); }
    if (IN(11)) { unsigned char* ws = pg8::kargs_fresh()->ws; pg8::Gemm g{(const bf16*)(ws + WS_G), (const bf16*)(ws + WS_W2B), M, D, FF}; pg8::StaticOrder S; S.init(M, D, F.G, (int)blockIdx.x); pg8::EpiResidN<2> E{};
            pg8::gemm_phase<pg8::EpiResidN<2>, pg8::StaticOrder, RES_ALIGN, true>(F.lds + RING_OFF, g, S, E, F.wave); AFTER(11); }
    if (IN(12)) { unsigned char* ws = pg8::kargs_fresh()->ws; const pg8::kargs_ptr ka = pg8::kargs_fresh(); const float* modf = (const float*)(ws + WS_MODF);
            phase_final(F, (const bf16*)(ws + WS_XS1), (const float*)(ws + WS_RSS4), ka->out, ka->in[9], modf + 0, modf + D); }
#undef IN
#undef AFTER
#undef GRID_BAR
}
#ifndef MK_MODE
#define MK_MODE 1
#endif
#ifndef NAIVE_MASK
#define NAIVE_MASK 0
#endif
#ifndef PROBE_REP
#define PROBE_REP 1
#endif
#ifndef REPEAT_MASK
#define REPEAT_MASK 0
#endif
extern "C" void kernel_launch(void* const* d_in, const int* in_sizes, int n_in, void* d_out, int out_size, void* d_ws, size_t ws_size, hipStream_t stream) {
    static int grid = 0;
    if (grid == 0) {
        if (n_in != 25 || in_sizes[0] != M * D || out_size != M * D || ws_size < WS_END) { fprintf(stderr, "kernel_launch: unexpected shapes (n_in %d, in0 %d, out %d, ws %zu)\n", n_in, n_in > 0 ? in_sizes[0] : -1, out_size, ws_size); grid = -1; return; }
        int dev = 0, cus = 0, per_cu = 0;
        if (hipGetDevice(&dev) != hipSuccess || hipDeviceGetAttribute(&cus, hipDeviceAttributeMultiprocessorCount, dev) != hipSuccess) { grid = -1; return; }
        if (hipFuncSetAttribute((const void*)skel_fwd, hipFuncAttributeMaxDynamicSharedMemorySize, LDS_BYTES) != hipSuccess) { fprintf(stderr, "kernel_launch: hipFuncSetAttribute failed\n"); grid = -1; return; }
        if (hipOccupancyMaxActiveBlocksPerMultiprocessor(&per_cu, (const void*)skel_fwd, NWAVES * 64, LDS_BYTES) != hipSuccess || per_cu < 1) { fprintf(stderr, "kernel_launch: occupancy query says %d blocks per CU\n", per_cu); per_cu = 1; }
        (void)hipGetLastError();
        grid = cus;
        fprintf(stderr, "kernel_launch: grid %d (occupancy query %d per CU), ws %zu\n", grid, per_cu, ws_size);
    }
    if (grid < 0) return;
    (void)hipMemsetAsync((char*)d_ws + WS_CTL, 0, CTL_ZERO_BYTES, stream);
    Args a{};
    for (int i = 0; i < 25; ++i) a.in[i] = (const float*)d_in[i];
    a.out = (float*)d_out; a.ws = (unsigned char*)d_ws;
#if MK_MODE == 1
    a.ph_lo = 0; a.ph_hi = NPHASE; a.use_bar = 1;
    hipLaunchKernelGGL(skel_fwd, dim3(grid), dim3(NWAVES * 64), LDS_BYTES, stream, a);
#else
    for (int k = 0; k < NPHASE; ++k) { a.ph_lo = k; a.ph_hi = k + 1; a.use_bar = 0;
        for (int rr = 0; rr <= ((REPEAT_MASK >> k) & 1); ++rr) hipLaunchKernelGGL(skel_fwd, dim3(grid), dim3(NWAVES * 64), LDS_BYTES, stream, a); }
#ifdef PROBE_ID
#ifdef PROBE_ZERO
    (void)hipMemsetAsync((char*)d_ws + WS_H, 0, (size_t)M * D * 2, stream); (void)hipMemsetAsync((char*)d_ws + WS_W13B, 0, (size_t)2 * FF * D * 2, stream);
#endif
    { static bool once = false; if (!once) { once = true; (void)hipFuncSetAttribute((const void*)probe_fwd, hipFuncAttributeMaxDynamicSharedMemorySize, LDS_BYTES); }
      for (int rr = 0; rr < PROBE_REP; ++rr) hipLaunchKernelGGL(probe_fwd, dim3(grid), dim3(NWAVES * 64), LDS_BYTES, stream, a); }
#endif
#endif
}
```

```cpp
#define ATTN_PRIO 1
#define ATTN_ORDER2 1
#define WGM_SET 4
#include <hip/hip_runtime.h>
#include <cstdio>
#include <cstdint>
#include <cmath>

constexpr int BATCH = 8, SEQ = 4096, D = 1024, M = BATCH * SEQ, FF = 2816, NIN = 3072, AW = 512, CWID = 512;
constexpr int NMOD = 9 * D, NMODF = 2 * D;
constexpr float NORM_EPS = 1e-6f, SUBLN_EPS = 1e-5f, LAMBDA_INIT = 0.2f;
constexpr float QSCALE = 0.125f * 1.4426950408889634f;

constexpr size_t MiB = 1u << 20;
constexpr size_t WS_CTL = 0, CTL_ZERO_BYTES = 128 * 1024;
constexpr int CW_ADA = 24576;
constexpr int CW_CMAX = 8192;
constexpr size_t WS_W13A = 1 * MiB, WS_W2A = 12 * MiB, WS_W13B = 18 * MiB, WS_W2B = 29 * MiB, WS_WIN = 35 * MiB, WS_WOUT = 41 * MiB;
constexpr size_t WS_ROPE = 43 * MiB;
constexpr size_t WS_MOD = 44 * MiB;
constexpr size_t WS_MODF = WS_MOD + (size_t)BATCH * NMOD * 4, WS_LAM = WS_MODF + (size_t)BATCH * NMODF * 4;
constexpr size_t WS_H = 48 * MiB;
constexpr size_t WS_G = 112 * MiB;
constexpr size_t WS_Q = 112 * MiB, WS_K = 144 * MiB, WS_V = 176 * MiB, WS_B = 208 * MiB, WS_C = 240 * MiB, WS_U = 272 * MiB;
constexpr size_t WS_AO = 304 * MiB;
constexpr size_t WS_MIX = 368 * MiB;
constexpr size_t WS_XS1 = 432 * MiB;
constexpr size_t WS_XS2 = WS_AO;
constexpr size_t WS_END = 496 * MiB;
constexpr size_t WS_SHWIN = 45 * MiB;
constexpr size_t WS_CS = WS_SHWIN + (size_t)BATCH * NIN * 4;
constexpr size_t WS_RSS2 = 46 * MiB, WS_RSS3 = WS_RSS2 + (size_t)M * 4, WS_RSS4 = WS_RSS3 + (size_t)M * 4;
constexpr size_t WS_RS1 = WS_RSS4 + 2 * (size_t)M * 4, WS_RS3 = WS_RS1 + (size_t)M * 4;

struct Args { const float* in[25]; float* out; unsigned char* ws; int ph_lo, ph_hi, use_bar, pad; };
typedef unsigned short bf16;
__device__ __forceinline__ float bf2f(unsigned v) { return __uint_as_float(v << 16); }
__device__ __forceinline__ unsigned f2bf(float f) { unsigned u = __float_as_uint(f); return (u + 0x7fffu + ((u >> 16) & 1u)) >> 16; }
__device__ __forceinline__ unsigned pk2(float lo, float hi) { return f2bf(lo) | (f2bf(hi) << 16); }
typedef float f32x4 __attribute__((ext_vector_type(4)));
typedef unsigned v4u __attribute__((ext_vector_type(4)));
typedef unsigned v2u __attribute__((ext_vector_type(2)));

__device__ __forceinline__ int mk_lane() { return (int)__builtin_amdgcn_mbcnt_hi(~0u, __builtin_amdgcn_mbcnt_lo(~0u, 0u)); }
__device__ __forceinline__ float wave_sum(float v) {
#pragma unroll
    for (int o = 1; o < 64; o <<= 1) v += __shfl_xor(v, o);
    return v;
}
__device__ __forceinline__ float silu_f(float v) { return v / (1.0f + __expf(-v)); }

template <bool TOBF>
__device__ __forceinline__ void norm_rows(const float* xs, void* out, const float* g, const float* shv, const float* scv, int r0, int nrows, int lane) {
    f32x4 gm[4], sh[4];
#pragma unroll
    for (int j = 0; j < 4; ++j) { const f32x4 gg = ((const f32x4*)g)[lane + 64 * j], sc = ((const f32x4*)scv)[lane + 64 * j]; gm[j] = gg * (sc + 1.0f); sh[j] = ((const f32x4*)shv)[lane + 64 * j]; }
    f32x4 v[4], w[4];
#pragma unroll
    for (int j = 0; j < 4; ++j) v[j] = ((const f32x4*)(xs + (size_t)r0 * D))[lane + 64 * j];
    for (int r = r0; r < r0 + nrows; ++r) {
        if (r + 1 < r0 + nrows) {
#pragma unroll
            for (int j = 0; j < 4; ++j) w[j] = ((const f32x4*)(xs + (size_t)(r + 1) * D))[lane + 64 * j]; }
        float s = 0.f;
#pragma unroll
        for (int j = 0; j < 4; ++j) s += (v[j].x * v[j].x + v[j].y * v[j].y) + (v[j].z * v[j].z + v[j].w * v[j].w);
        const float rs = 1.0f / sqrtf(wave_sum(s) * (1.f / D) + NORM_EPS);
#pragma unroll
        for (int j = 0; j < 4; ++j) {
            const f32x4 o = v[j] * rs * gm[j] + sh[j];
            if (TOBF) { v2u q; q.x = pk2(o.x, o.y); q.y = pk2(o.z, o.w); ((v2u*)((bf16*)out + (size_t)r * D))[lane + 64 * j] = q; }
            else ((f32x4*)((float*)out + (size_t)r * D))[lane + 64 * j] = o;
        }
#pragma unroll
        for (int j = 0; j < 4; ++j) v[j] = w[j];
    }
}


__device__ __forceinline__ unsigned q8pack(float a, float b, float c4, float d, float inv) {
    const int q0 = (int)rintf(a * inv), q1 = (int)rintf(b * inv), q2 = (int)rintf(c4 * inv), q3 = (int)rintf(d * inv);
    return (unsigned)(q0 & 255) | ((unsigned)(q1 & 255) << 8) | ((unsigned)(q2 & 255) << 16) | ((unsigned)q3 << 24);
}
__device__ __forceinline__ float wave_max(float v) {
#pragma unroll
    for (int o = 1; o < 64; o <<= 1) v = fmaxf(v, __shfl_xor(v, o));
    return v;
}
__device__ __forceinline__ void norm_rows_q8(const float* xs, signed char* H8, float* rs, const float* g, const float* shv, const float* scv, int r0, int nrows, int lane) {
    f32x4 gm[4], sh[4];
#pragma unroll
    for (int j = 0; j < 4; ++j) { const f32x4 gg = ((const f32x4*)g)[lane + 64 * j], sc = ((const f32x4*)scv)[lane + 64 * j]; gm[j] = gg * (sc + 1.0f); sh[j] = ((const f32x4*)shv)[lane + 64 * j]; }
    f32x4 buf[4][4];
#pragma unroll
    for (int q = 0; q < 3; ++q)
#pragma unroll
        for (int j = 0; j < 4; ++j) buf[q][j] = ((const f32x4*)(xs + (size_t)(r0 + q) * D))[lane + 64 * j];
    for (int rr = r0; rr < r0 + nrows; rr += 4) {
#pragma unroll
        for (int q = 0; q < 4; ++q) { const int r = rr + q;
            if (r + 3 < r0 + nrows) {
#pragma unroll
                for (int j = 0; j < 4; ++j) buf[(q + 3) & 3][j] = ((const f32x4*)(xs + (size_t)(r + 3) * D))[lane + 64 * j]; }
            const f32x4 (&v)[4] = buf[q];
            float s = 0.f;
#pragma unroll
            for (int j = 0; j < 4; ++j) s += (v[j].x * v[j].x + v[j].y * v[j].y) + (v[j].z * v[j].z + v[j].w * v[j].w);
            const float rn = 1.0f / sqrtf(wave_sum(s) * (1.f / D) + NORM_EPS);
            f32x4 o[4]; float mx = 0.f;
#pragma unroll
            for (int j = 0; j < 4; ++j) { o[j] = v[j] * rn * gm[j] + sh[j]; mx = fmaxf(fmaxf(mx, fmaxf(fabsf(o[j].x), fabsf(o[j].y))), fmaxf(fabsf(o[j].z), fabsf(o[j].w))); }
            mx = wave_max(mx); const float scale = mx > 0.f ? mx * (1.0f / 127.0f) : 1.0f, inv = 1.0f / scale;
#pragma unroll
            for (int j = 0; j < 4; ++j) ((unsigned*)(H8 + (size_t)r * D))[lane + 64 * j] = q8pack(o[j].x, o[j].y, o[j].z, o[j].w, inv);
            if (lane == 0) rs[r] = scale;
        }
    }
}
__device__ __forceinline__ void norm_rows_q8_bf(const bf16* xs, const float* rss, signed char* H8, float* rs, const float* g, const float* shv, const float* scv, int r0, int nrows, int lane);
__device__ __forceinline__ void unpack8(const v4u w, float (&f)[8]) {
    f[0] = bf2f(w.x & 0xffffu); f[1] = bf2f(w.x >> 16); f[2] = bf2f(w.y & 0xffffu); f[3] = bf2f(w.y >> 16);
    f[4] = bf2f(w.z & 0xffffu); f[5] = bf2f(w.z >> 16); f[6] = bf2f(w.w & 0xffffu); f[7] = bf2f(w.w >> 16);
}
__device__ __forceinline__ v4u pack8(const float (&f)[8]) { v4u w; w.x = pk2(f[0], f[1]); w.y = pk2(f[2], f[3]); w.z = pk2(f[4], f[5]); w.w = pk2(f[6], f[7]); return w; }
__device__ __forceinline__ void conv_rows(const bf16* Bb, const bf16* Cb, const bf16* Ub, bf16* MIX, const float* conv_w, const float* conv_g, int r0, int nrows, int lane) {
    float w0[8], w1[8], w2[8], cg[8];
#pragma unroll
    for (int i = 0; i < 8; ++i) { w0[i] = conv_w[8 * lane + i]; w1[i] = conv_w[CWID + 8 * lane + i]; w2[i] = conv_w[2 * CWID + 8 * lane + i]; cg[i] = conv_g[8 * lane + i]; }
    float cu1[8], cu2[8];
    {
        const int t0 = r0 & (SEQ - 1);
#pragma unroll
        for (int i = 0; i < 8; ++i) { cu1[i] = 0.f; cu2[i] = 0.f; }
        if (t0 >= 1) { float c[8], u[8]; unpack8(((const v4u*)(Cb + (size_t)(r0 - 1) * CWID))[lane], c); unpack8(((const v4u*)(Ub + (size_t)(r0 - 1) * CWID))[lane], u);
#pragma unroll
            for (int i = 0; i < 8; ++i) cu1[i] = c[i] * u[i]; }
        if (t0 >= 2) { float c[8], u[8]; unpack8(((const v4u*)(Cb + (size_t)(r0 - 2) * CWID))[lane], c); unpack8(((const v4u*)(Ub + (size_t)(r0 - 2) * CWID))[lane], u);
#pragma unroll
            for (int i = 0; i < 8; ++i) cu2[i] = c[i] * u[i]; }
    }
    v4u qc = ((const v4u*)(Cb + (size_t)r0 * CWID))[lane], qu = ((const v4u*)(Ub + (size_t)r0 * CWID))[lane], qb = ((const v4u*)(Bb + (size_t)r0 * CWID))[lane];
    for (int r = r0; r < r0 + nrows; ++r) {
        v4u nc, nu, nb;
        if (r + 1 < r0 + nrows) { nc = ((const v4u*)(Cb + (size_t)(r + 1) * CWID))[lane]; nu = ((const v4u*)(Ub + (size_t)(r + 1) * CWID))[lane]; nb = ((const v4u*)(Bb + (size_t)(r + 1) * CWID))[lane]; }
        float c[8], u[8], bb[8], y[8]; unpack8(qc, c); unpack8(qu, u); unpack8(qb, bb);
        float s2 = 0.f;
#pragma unroll
        for (int i = 0; i < 8; ++i) { const float cu0 = c[i] * u[i]; y[i] = bb[i] * (w0[i] * cu2[i] + w1[i] * cu1[i] + w2[i] * cu0); cu2[i] = cu1[i]; cu1[i] = cu0; s2 += y[i] * y[i]; }
        s2 += __shfl_xor(s2, 1); s2 += __shfl_xor(s2, 2); s2 += __shfl_xor(s2, 4);
        const float rc = 1.0f / sqrtf(s2 * (1.f / 64.f) + NORM_EPS);
#pragma unroll
        for (int i = 0; i < 8; ++i) y[i] = y[i] * rc * cg[i];
        ((v4u*)(MIX + (size_t)r * D + AW))[lane] = pack8(y);
        qc = nc; qu = nu; qb = nb;
    }
}
struct Conv4 { v4u qc[6], qu[6], qb[4]; };
__device__ __forceinline__ void conv4_load(Conv4& Q, const bf16* Bb, const bf16* Cb, const bf16* Ub, int r0, int lane) {
    const bool halo = (r0 & (SEQ - 1)) != 0;
#pragma unroll
    for (int k = 0; k < 6; ++k) { const int r = r0 - 2 + k; if (k >= 2 || halo) { Q.qc[k] = ((const v4u*)(Cb + (size_t)r * CWID))[lane]; Q.qu[k] = ((const v4u*)(Ub + (size_t)r * CWID))[lane]; } else { Q.qc[k] = (v4u){0u, 0u, 0u, 0u}; Q.qu[k] = (v4u){0u, 0u, 0u, 0u}; } }
#pragma unroll
    for (int k = 0; k < 4; ++k) Q.qb[k] = ((const v4u*)(Bb + (size_t)(r0 + k) * CWID))[lane];
}
__device__ __forceinline__ void conv4_finish(const Conv4& Q, bf16* MIX, const float* conv_w, const float* conv_g, int r0, int lane) {
    float w0[8], w1[8], w2[8], cg[8];
#pragma unroll
    for (int i = 0; i < 8; ++i) { w0[i] = conv_w[8 * lane + i]; w1[i] = conv_w[CWID + 8 * lane + i]; w2[i] = conv_w[2 * CWID + 8 * lane + i]; cg[i] = conv_g[8 * lane + i]; }
    float cu2[8], cu1[8];
    { float c[8], u[8]; unpack8(Q.qc[0], c); unpack8(Q.qu[0], u);
#pragma unroll
      for (int i = 0; i < 8; ++i) cu2[i] = c[i] * u[i];
      unpack8(Q.qc[1], c); unpack8(Q.qu[1], u);
#pragma unroll
      for (int i = 0; i < 8; ++i) cu1[i] = c[i] * u[i]; }
#pragma unroll
    for (int k = 0; k < 4; ++k) {
        float c[8], u[8], bb[8], y[8]; unpack8(Q.qc[k + 2], c); unpack8(Q.qu[k + 2], u); unpack8(Q.qb[k], bb);
        float s2 = 0.f;
#pragma unroll
        for (int i = 0; i < 8; ++i) { const float cu0 = c[i] * u[i]; y[i] = bb[i] * (w0[i] * cu2[i] + w1[i] * cu1[i] + w2[i] * cu0); cu2[i] = cu1[i]; cu1[i] = cu0; s2 += y[i] * y[i]; }
        s2 += __shfl_xor(s2, 1); s2 += __shfl_xor(s2, 2); s2 += __shfl_xor(s2, 4);
        const float rc = 1.0f / sqrtf(s2 * (1.f / 64.f) + NORM_EPS);
#pragma unroll
        for (int i = 0; i < 8; ++i) y[i] = y[i] * rc * cg[i];
        ((v4u*)(MIX + (size_t)(r0 + k) * D + AW))[lane] = pack8(y);
    }
}
__device__ __forceinline__ void norm_rows_q8_bf(const bf16* xs, const float* rss, signed char* H8, float* rs, const float* g, const float* shv, const float* scv, int r0, int nrows, int lane) {
    float gm[16], sh[16];
#pragma unroll
    for (int j = 0; j < 2; ++j)
#pragma unroll
        for (int e = 0; e < 8; ++e) { const int cidx = 512 * j + 8 * lane + e; gm[8 * j + e] = g[cidx] * (scv[cidx] + 1.0f); sh[8 * j + e] = shv[cidx]; }
    v4u q0 = *(const v4u*)(xs + (size_t)r0 * D + 8 * lane), q1 = *(const v4u*)(xs + (size_t)r0 * D + 512 + 8 * lane); float ssq = rss[r0];
    for (int r = r0; r < r0 + nrows; ++r) { v4u n0, n1; float nss;
        if (r + 1 < r0 + nrows) { n0 = *(const v4u*)(xs + (size_t)(r + 1) * D + 8 * lane); n1 = *(const v4u*)(xs + (size_t)(r + 1) * D + 512 + 8 * lane); nss = rss[r + 1]; }
        const float rn = 1.0f / sqrtf(ssq * (1.f / D) + NORM_EPS);
        float o[16]; float mx = 0.f;
        { float f[8]; unpack8(q0, f);
#pragma unroll
          for (int e = 0; e < 8; ++e) { o[e] = f[e] * rn * gm[e] + sh[e]; mx = fmaxf(mx, fabsf(o[e])); }
          unpack8(q1, f);
#pragma unroll
          for (int e = 0; e < 8; ++e) { o[8 + e] = f[e] * rn * gm[8 + e] + sh[8 + e]; mx = fmaxf(mx, fabsf(o[8 + e])); } }
        mx = wave_max(mx); const float scale = mx > 0.f ? mx * (1.0f / 127.0f) : 1.0f, inv = 1.0f / scale;
#pragma unroll
        for (int j = 0; j < 2; ++j) { v2u w; w.x = q8pack(o[8 * j], o[8 * j + 1], o[8 * j + 2], o[8 * j + 3], inv); w.y = q8pack(o[8 * j + 4], o[8 * j + 5], o[8 * j + 6], o[8 * j + 7], inv);
            *(v2u*)(H8 + (size_t)r * D + 512 * j + 8 * lane) = w; }
        if (lane == 0) rs[r] = scale;
        q0 = n0; q1 = n1; ssq = nss;
    }
}
__device__ __forceinline__ float lam_value(const float* lq1, const float* lk1, const float* lq2, const float* lk2) {
    float s1 = 0.f, s2 = 0.f;
    for (int i = 0; i < 64; ++i) { s1 += lq1[i] * lk1[i]; s2 += lq2[i] * lk2[i]; }
    return expf(s1) - expf(s2) + LAMBDA_INIT;
}
namespace pg8 {
#define PG8_LAS __attribute__((address_space(3)))
typedef unsigned short bf16_t;
typedef short bf16x8 __attribute__((ext_vector_type(8)));
typedef float f32x4 __attribute__((ext_vector_type(4)));
typedef unsigned u32x4 __attribute__((ext_vector_type(4)));
#ifndef WGM_SET
#define WGM_SET 8
#endif
constexpr int BM = 256, BK = 64, HALF = 128, HTB = HALF * BK * 2  , STAGE_BYTES = 8 * HTB, NXCD = 8, WGM = WGM_SET;
constexpr int SIDE_REL = STAGE_BYTES + 1024;

__host__ __device__ __forceinline__ int lds_byte(int r, int c) { const int st = (r >> 4) * 2 + (c >> 5), rr = r & 15, cc = c & 31, ob = rr * 64 + cc * 2; return st * 1024 + (ob ^ (((ob >> 9) & 1) << 5)); }
__host__ __device__ __forceinline__ void stage_rc(int b, int& R, int& C) { const int st = b / 1024, sb = b % 1024, swz = sb ^ (((sb >> 9) & 1) << 5); R = (st >> 1) * 16 + swz / 64; C = (st & 1) * 32 + (swz % 64) / 2; }
__host__ __device__ __forceinline__ int perm32(int rho) { const int n = rho >> 4, i = rho & 15; return 8 * (i >> 2) + 4 * n + (i & 3); }

struct Unit { int pm, pn; };
struct Gemm { const bf16_t* A; const bf16_t* Bt; int M, N, K; };

struct StaticOrder {
    int nM, nN, nwg, G, c;
    __host__ __device__ void init(int M, int N, int G_, int c_) { nM = M / BM; nN = N / BM; nwg = nM * nN; G = G_; c = c_; }
    __host__ __device__ bool next(int i, Unit& u) const {
        const long L = (long)i * G + c; if (L >= nwg) return false;
        int wgid = (int)L; { const int q = nwg / NXCD, r = nwg % NXCD, xcd = wgid % NXCD, off = wgid / NXCD; wgid = (xcd < r ? xcd * (q + 1) : r * (q + 1) + (xcd - r) * q) + off; }
        const int nig = WGM * nN, gid = wgid / nig, fm = gid * WGM, gsz = (nM - fm) < WGM ? (nM - fm) : WGM;
        u.pm = fm + ((wgid % nig) % gsz); u.pn = (wgid % nig) / gsz; return true;
    }
    __device__ __forceinline__ void a_ready(const Unit&) const {}
    __device__ __forceinline__ void done(const Unit&) const {}
};

__device__ __forceinline__ unsigned cvt_pk_bf16(float lo, float hi) { unsigned r; asm volatile("v_cvt_pk_bf16_f32 %0, %1, %2" : "=v"(r) : "v"(lo), "v"(hi)); return r; }
typedef int i32x4 __attribute__((ext_vector_type(4)));
#ifdef WT_STORES
__device__ __forceinline__ void st16(void* p, u32x4 v) { asm volatile("global_store_dwordx4 %0, %1, off sc1\n\ts_nop 1" :: "v"(p), "v"(v) : "memory"); }
#else
__device__ __forceinline__ void st16(void* p, u32x4 v) { *(u32x4*)p = v; }
#endif
template <class E, class = void> struct AccOf { typedef f32x4 type; };
template <class E> struct AccOf<E, typename E::i8_tag> { typedef i32x4 type; };
template <class E, class = void> struct Prefetch { static constexpr bool v = false; };
template <class E> struct Prefetch<E, typename E::pref_tag> { static constexpr bool v = true; };
template <class E, class = void> struct ZeroByMov { static constexpr bool v = false; };
template <class E> struct ZeroByMov<E, typename E::zmov_tag> { static constexpr bool v = true; };
__device__ __forceinline__ f32x4 mma16(bf16x8 b, bf16x8 a, f32x4 c) { return __builtin_amdgcn_mfma_f32_16x16x32_bf16(b, a, c, 0, 0, 0); }
__device__ __forceinline__ i32x4 mma16(bf16x8 b, bf16x8 a, i32x4 c) { return __builtin_amdgcn_mfma_i32_16x16x64_i8(__builtin_bit_cast(i32x4, b), __builtin_bit_cast(i32x4, a), c, 0, 0, 0); }
typedef const __attribute__((address_space(4))) ::Args* kargs_ptr;
__device__ __forceinline__ kargs_ptr kargs_fresh() { kargs_ptr p = (kargs_ptr)__builtin_amdgcn_kernarg_segment_ptr(); asm volatile("" : "+s"(p)); return p; }
__device__ __forceinline__ float sum_fq(float v) {
    { auto r = __builtin_amdgcn_permlane16_swap(__float_as_uint(v), __float_as_uint(v), false, false); v = __uint_as_float(r[0]) + __uint_as_float(r[1]); }
    { auto r = __builtin_amdgcn_permlane32_swap(__float_as_uint(v), __float_as_uint(v), false, false); v = __uint_as_float(r[0]) + __uint_as_float(r[1]); }
    return v;
}
__device__ __forceinline__ float silu_fast(float v) { return v * __builtin_amdgcn_rcpf(1.0f + __builtin_amdgcn_exp2f(v * -1.4426950408889634f)); }
__device__ __forceinline__ float rs_of(float ss) { return __builtin_amdgcn_rsqf(ss * (1.0f / 1024.0f) + 1e-6f); }
#ifndef NO_SIDE_LDS
#define SIDE_LDS 1
#define SIDE_LDS_Z 1
#define EPIZ_PEEL 1
#endif
#ifndef NO_SWIGLU_V2
#define SWIGLU_V2 1
#endif
template <int WHICH, int EABL = 0> struct EpiSwiGLUq {
    typedef void i8_tag; static constexpr bool PERM = true, AFTER_DRAIN = false;
#ifdef SIDE_LDS
    static constexpr bool SIDE = true;
#else
    static constexpr bool SIDE = false;
#endif
    static __device__ __forceinline__ const char* side_src(const Unit& u, int wid) { unsigned char* ws = kargs_fresh()->ws;
        const float* rs = (const float*)(ws + (WHICH == 0 ? WS_RS1 : WS_RS3)); const float* cs = (const float*)(ws + WS_CS) + WHICH * 2 * FF;
        return (const char*)(wid < 4 ? rs + u.pm * BM + 64 * wid : cs + u.pn * BM + 64 * (wid - 4)); }
    __device__ __forceinline__ void operator()(const i32x4 (&acc)[2][2][4][2], const Unit& u, int wr, int wc, int fr, int fq, PG8_LAS unsigned char* sb = nullptr) const {
        unsigned char* ws = kargs_fresh()->ws; bf16_t* O = (bf16_t*)(ws + WS_G); constexpr int ldc = FF;
        const float* rs = (const float*)(ws + (WHICH == 0 ? WS_RS1 : WS_RS3)); const float* cs = (const float*)(ws + WS_CS) + WHICH * 2 * FF;
        const int row0 = u.pm * BM + wr * 64 + fr, col0 = u.pn * HALF + wc * 32 + 8 * fq, bcol0 = u.pn * BM + wc * 32 + 8 * fq;
        f32x4 c1[2], c3[2]; float rr[8];
        if (EABL == 1 || EABL == 5) {
#pragma unroll
            for (int n = 0; n < 2; ++n) { c1[n] = (f32x4){0.001f, 0.002f, 0.003f, 0.001f} * (float)(fr + 1); c3[n] = (f32x4){0.002f, 0.001f, 0.003f, 0.002f} * (float)(fq + 1); }
#pragma unroll
            for (int g = 0; g < 8; ++g) rr[g] = 0.01f * (float)(g + 1 + fr);
        } else if (SIDE) {
#pragma unroll
            for (int n = 0; n < 2; ++n) { c1[n] = *(const PG8_LAS f32x4*)(sb + 1024 + 4 * (wc * 32 + 8 * fq + 4 * n)); c3[n] = *(const PG8_LAS f32x4*)(sb + 1024 + 4 * (HALF + wc * 32 + 8 * fq + 4 * n)); }
#pragma unroll
            for (int g = 0; g < 8; ++g) rr[g] = *(const PG8_LAS float*)(sb + 4 * (wr * 64 + fr + (g >> 2) * HALF + (g & 3) * 16));
        } else {
#pragma unroll
        for (int n = 0; n < 2; ++n) { c1[n] = *(const f32x4*)(cs + bcol0 + 4 * n); c3[n] = *(const f32x4*)(cs + bcol0 + HALF + 4 * n); }
#pragma unroll
        for (int g = 0; g < 8; ++g) rr[g] = rs[row0 + (g >> 2) * HALF + (g & 3) * 16];
        }
#ifdef SWIGLU_V2
        f32x4 c1l[2], c13[2];
#pragma unroll
        for (int n = 0; n < 2; ++n) { c1l[n] = c1[n] * -1.4426950408889634f; c13[n] = c1[n] * c3[n]; }
#pragma unroll
        for (int ai = 0; ai < 2; ++ai)
#pragma unroll
            for (int m = 0; m < 4; ++m) { bf16_t* rowp = O + (size_t)(row0 + ai * HALF + m * 16) * ldc + col0; const float r = rr[ai * 4 + m], r2 = r * r;
                u32x4 w; unsigned wv[4];
#pragma unroll
                for (int n = 0; n < 2; ++n) { const i32x4 ia = acc[ai][0][m][n], ib = acc[ai][1][m][n];
                    const f32x4 fa = (f32x4){(float)ia[0], (float)ia[1], (float)ia[2], (float)ia[3]}, fb = (f32x4){(float)ib[0], (float)ib[1], (float)ib[2], (float)ib[3]};
                    f32x4 o;
                    if (EABL == 3) o = fa + fb; else {
                    const f32x4 t = fa * (c1l[n] * r); const f32x4 p = (fa * fb) * (c13[n] * r2);
                    const f32x4 d = (f32x4){__builtin_amdgcn_exp2f(t[0]), __builtin_amdgcn_exp2f(t[1]), __builtin_amdgcn_exp2f(t[2]), __builtin_amdgcn_exp2f(t[3])} + 1.0f;
                    o = p * (f32x4){__builtin_amdgcn_rcpf(d[0]), __builtin_amdgcn_rcpf(d[1]), __builtin_amdgcn_rcpf(d[2]), __builtin_amdgcn_rcpf(d[3])}; }
                    wv[2 * n] = cvt_pk_bf16(o[0], o[1]); wv[2 * n + 1] = cvt_pk_bf16(o[2], o[3]); }
                w.x = wv[0]; w.y = wv[1]; w.z = wv[2]; w.w = wv[3];
                if (EABL == 2 || EABL == 5) asm volatile("" :: "v"(w.x), "v"(w.y), "v"(w.z), "v"(w.w)); else st16(rowp, w); }
#else
#pragma unroll
        for (int ai = 0; ai < 2; ++ai)
#pragma unroll
            for (int m = 0; m < 4; ++m) { bf16_t* rowp = O + (size_t)(row0 + ai * HALF + m * 16) * ldc + col0; const float r = rr[ai * 4 + m];
                const i32x4 ia0 = acc[ai][0][m][0], ia1 = acc[ai][0][m][1], ib0 = acc[ai][1][m][0], ib1 = acc[ai][1][m][1];
                const f32x4 a0 = (f32x4){(float)ia0[0], (float)ia0[1], (float)ia0[2], (float)ia0[3]} * r * c1[0], a1 = (f32x4){(float)ia1[0], (float)ia1[1], (float)ia1[2], (float)ia1[3]} * r * c1[1];
                const f32x4 b0 = (f32x4){(float)ib0[0], (float)ib0[1], (float)ib0[2], (float)ib0[3]} * r * c3[0], b1 = (f32x4){(float)ib1[0], (float)ib1[1], (float)ib1[2], (float)ib1[3]} * r * c3[1];
                u32x4 w;
                w.x = cvt_pk_bf16(silu_fast(a0[0]) * b0[0], silu_fast(a0[1]) * b0[1]); w.y = cvt_pk_bf16(silu_fast(a0[2]) * b0[2], silu_fast(a0[3]) * b0[3]);
                w.z = cvt_pk_bf16(silu_fast(a1[0]) * b1[0], silu_fast(a1[1]) * b1[1]); w.w = cvt_pk_bf16(silu_fast(a1[2]) * b1[2], silu_fast(a1[3]) * b1[3]);
                *(u32x4*)rowp = w; }
#endif
    }
    static constexpr int PEND_LD = FF * 2;
    static __device__ __forceinline__ constexpr size_t pend_off(int j) { return (size_t)((j >> 2) * HALF + (j & 3) * 16) * FF * 2; }
    __device__ __forceinline__ char* compute(const i32x4 (&acc)[2][2][4][2], const Unit& u, int wr, int wc, int fr, int fq, u32x4 (&pend)[8]) const {
        unsigned char* ws = kargs_fresh()->ws; bf16_t* O = (bf16_t*)(ws + WS_G); constexpr int ldc = FF;
        const float* rs = (const float*)(ws + (WHICH == 0 ? WS_RS1 : WS_RS3)); const float* cs = (const float*)(ws + WS_CS) + WHICH * 2 * FF;
        const int row0 = u.pm * BM + wr * 64 + fr, col0 = u.pn * HALF + wc * 32 + 8 * fq, bcol0 = u.pn * BM + wc * 32 + 8 * fq;
        f32x4 c1[2], c3[2]; float rr[8];
#pragma unroll
        for (int n = 0; n < 2; ++n) { c1[n] = *(const f32x4*)(cs + bcol0 + 4 * n); c3[n] = *(const f32x4*)(cs + bcol0 + HALF + 4 * n); }
#pragma unroll
        for (int g = 0; g < 8; ++g) rr[g] = rs[row0 + (g >> 2) * HALF + (g & 3) * 16];
#pragma unroll
        for (int ai = 0; ai < 2; ++ai)
#pragma unroll
            for (int m = 0; m < 4; ++m) { const float r = rr[ai * 4 + m];
                const i32x4 ia0 = acc[ai][0][m][0], ia1 = acc[ai][0][m][1], ib0 = acc[ai][1][m][0], ib1 = acc[ai][1][m][1];
                const f32x4 a0 = (f32x4){(float)ia0[0], (float)ia0[1], (float)ia0[2], (float)ia0[3]} * r * c1[0], a1 = (f32x4){(float)ia1[0], (float)ia1[1], (float)ia1[2], (float)ia1[3]} * r * c1[1];
                const f32x4 b0 = (f32x4){(float)ib0[0], (float)ib0[1], (float)ib0[2], (float)ib0[3]} * r * c3[0], b1 = (f32x4){(float)ib1[0], (float)ib1[1], (float)ib1[2], (float)ib1[3]} * r * c3[1];
                u32x4 w;
                w.x = cvt_pk_bf16(silu_fast(a0[0]) * b0[0], silu_fast(a0[1]) * b0[1]); w.y = cvt_pk_bf16(silu_fast(a0[2]) * b0[2], silu_fast(a0[3]) * b0[3]);
                w.z = cvt_pk_bf16(silu_fast(a1[0]) * b1[0], silu_fast(a1[1]) * b1[1]); w.w = cvt_pk_bf16(silu_fast(a1[2]) * b1[2], silu_fast(a1[3]) * b1[3]);
                pend[ai * 4 + m] = w; }
        return (char*)(O + (size_t)(u.pm * BM + wr * 64) * ldc + (u.pn * HALF + wc * 32));
    }
};
template <int WHICH, bool DUMMY_RSS = false> struct EpiResidN {
    static constexpr bool PERM = true, AFTER_DRAIN = false, SIDE = false, BASE_F32 = (WHICH == 0), WRITE_XG = (WHICH == 0);
#ifdef EPI_PREF
    typedef void pref_tag;
#endif
    static __device__ __forceinline__ const char* pref_src(const Unit& u, int t, int wid, int lane, unsigned& voff) {
        const kargs_ptr ka = kargs_fresh(); const char* base = WHICH == 0 ? (const char*)ka->in[0] : (const char*)(ka->ws + (WHICH == 1 ? WS_XS1 : WS_XS2));
        constexpr int NP = BASE_F32 ? 256 : 128, NT_ = (WHICH == 1 ? D : FF) / BK, T0 = NT_ - NP / 8;
        int p = (t - T0) * 8 + wid; if (p < 0) p = wid;
        if (BASE_F32) { voff = (unsigned)lane * 16u; return base + ((size_t)(u.pm * BM + p) * 1024 + (size_t)u.pn * BM) * 4; }
        voff = (unsigned)((lane >> 5) * 2048 + (lane & 31) * 16); return base + ((size_t)(u.pm * BM + 2 * p) * 1024 + (size_t)u.pn * BM) * 2;
    }
#ifndef RESID_CH_F32
#define RESID_CH_F32 2
#endif
#ifndef RESID_CH_BF
#define RESID_CH_BF 4
#endif
    static constexpr int CH = BASE_F32 ? RESID_CH_F32 : RESID_CH_BF;
    struct Chunk { f32x4 f[CH][2][2]; u32x4 h[CH][2]; };
    __device__ __forceinline__ void load_chunk(Chunk& C, const void* base, int row0, int col0, int g0) const {
#pragma unroll
        for (int q = 0; q < CH; ++q) { const int gi = g0 + q; const size_t off = (size_t)(row0 + (gi >> 2) * HALF + (gi & 3) * 16) * 1024 + col0;
            if (BASE_F32) {
#pragma unroll
                for (int bj = 0; bj < 2; ++bj)
#pragma unroll
                    for (int n = 0; n < 2; ++n) C.f[q][bj][n] = *(const f32x4*)((const float*)base + off + bj * HALF + 4 * n);
            } else {
#pragma unroll
                for (int bj = 0; bj < 2; ++bj) C.h[q][bj] = *(const u32x4*)((const bf16_t*)base + off + bj * HALF);
            } }
    }
    __device__ __forceinline__ void operator()(const f32x4 (&acc)[2][2][4][2], const Unit& u, int wr, int wc, int fr, int fq) const {
        const kargs_ptr ka = kargs_fresh(); unsigned char* ws = ka->ws; const float* mod = (const float*)(ws + WS_MOD); constexpr int ldmod = NMOD;
        const void* base = WHICH == 0 ? (const void*)ka->in[0] : (const void*)(ws + (WHICH == 1 ? WS_XS1 : WS_XS2));
        bf16_t* xs_out = (bf16_t*)(ws + (WHICH == 1 ? WS_XS2 : WS_XS1)); bf16_t* xg = (bf16_t*)(ws + WS_H);
        const float* gate = mod + (WHICH == 0 ? 2 : WHICH == 1 ? 5 : 8) * D; const float scale = WHICH == 1 ? 1.0f : 0.5f;
        const float* g = WHICH == 0 ? ka->in[7] : ka->in[8]; const float* sc = mod + (WHICH == 0 ? 4 : 7) * D;
        float* rss = (float*)(ws + (DUMMY_RSS ? WS_RSS4 + (size_t)M * 4 : WHICH == 0 ? WS_RSS2 : WHICH == 1 ? WS_RSS3 : WS_RSS4));
        const int row0 = u.pm * BM + wr * 64 + fr, col0 = u.pn * BM + wc * 32 + 8 * fq, b = u.pm >> 4;
        Chunk ck;
        load_chunk(ck, base, row0, col0, 0);
        f32x4 gv[2][2], gm[2][2];
#pragma unroll
        for (int bj = 0; bj < 2; ++bj)
#pragma unroll
            for (int n = 0; n < 2; ++n) { const int c = col0 + bj * HALF + 4 * n; gv[bj][n] = *(const f32x4*)(gate + (size_t)b * ldmod + c) * scale;
                if (WRITE_XG) gm[bj][n] = *(const f32x4*)(g + c) * (*(const f32x4*)(sc + (size_t)b * ldmod + c) + 1.0f); }
#pragma unroll
        for (int g0 = 0; g0 < 8; g0 += CH) {
            if (g0 > 0) load_chunk(ck, base, row0, col0, g0);
#pragma unroll
            for (int q = 0; q < CH; ++q) { const int gi = g0 + q, ai = gi >> 2, m = gi & 3, row = row0 + ai * HALF + m * 16; const size_t off = (size_t)row * 1024 + col0;
                float ss = 0.f;
#pragma unroll
                for (int bj = 0; bj < 2; ++bj) {
                    f32x4 b0, b1;
                    if (BASE_F32) { b0 = ck.f[q][bj][0]; b1 = ck.f[q][bj][1]; }
                    else { const u32x4 hh = ck.h[q][bj]; b0 = (f32x4){__uint_as_float(hh.x << 16), __uint_as_float(hh.x & 0xffff0000u), __uint_as_float(hh.y << 16), __uint_as_float(hh.y & 0xffff0000u)};
                           b1 = (f32x4){__uint_as_float(hh.z << 16), __uint_as_float(hh.z & 0xffff0000u), __uint_as_float(hh.w << 16), __uint_as_float(hh.w & 0xffff0000u)}; }
                    const f32x4 v0 = b0 + gv[bj][0] * acc[ai][bj][m][0], v1 = b1 + gv[bj][1] * acc[ai][bj][m][1];
                    u32x4 w; w.x = cvt_pk_bf16(v0[0], v0[1]); w.y = cvt_pk_bf16(v0[2], v0[3]); w.z = cvt_pk_bf16(v1[0], v1[1]); w.w = cvt_pk_bf16(v1[2], v1[3]);
                    st16(xs_out + off + bj * HALF, w);
                    const f32x4 r0 = (f32x4){__uint_as_float(w.x << 16), __uint_as_float(w.x & 0xffff0000u), __uint_as_float(w.y << 16), __uint_as_float(w.y & 0xffff0000u)};
                    const f32x4 r1 = (f32x4){__uint_as_float(w.z << 16), __uint_as_float(w.z & 0xffff0000u), __uint_as_float(w.w << 16), __uint_as_float(w.w & 0xffff0000u)};
                    ss += (r0[0] * r0[0] + r0[1] * r0[1]) + (r0[2] * r0[2] + r0[3] * r0[3]) + (r1[0] * r1[0] + r1[1] * r1[1]) + (r1[2] * r1[2] + r1[3] * r1[3]);
                    if (WRITE_XG) { const f32x4 y0 = r0 * gm[bj][0], y1 = r1 * gm[bj][1]; u32x4 q2; q2.x = cvt_pk_bf16(y0[0], y0[1]); q2.y = cvt_pk_bf16(y0[2], y0[3]); q2.z = cvt_pk_bf16(y1[0], y1[1]); q2.w = cvt_pk_bf16(y1[2], y1[3]);
                        st16(xg + off + bj * HALF, q2); }
                }
                ss = sum_fq(ss);
#ifdef PROBE_NO_RSS_ATOMICS
                if (DUMMY_RSS) { if (fq == 0) rss[row] = ss; } else
#endif
                if (fq == 0) (void)__hip_atomic_fetch_add(rss + row, ss, __ATOMIC_RELAXED, __HIP_MEMORY_SCOPE_AGENT);
            }
        }
    }
};
struct EpiZ {
#ifndef EPIZ_PEEL
    typedef void zmov_tag;
#endif
#ifdef SIDE_LDS_Z
    static constexpr bool PERM = true, AFTER_DRAIN = false, SIDE = true;
#else
    static constexpr bool PERM = true, AFTER_DRAIN = false, SIDE = false;
#endif
    static __device__ __forceinline__ const char* side_src(const Unit& u, int wid) { unsigned char* ws = kargs_fresh()->ws;
        const float* rss = (const float*)(ws + WS_RSS2); const float* shw = (const float*)(ws + WS_SHWIN);
        return (const char*)(wid < 4 ? rss + u.pm * BM + 64 * wid : shw + (size_t)(u.pm >> 4) * NIN + u.pn * BM + 64 * (wid - 4)); }
    __device__ __forceinline__ void operator()(const f32x4 (&acc)[2][2][4][2], const Unit& u, int wr, int wc, int fr, int fq, PG8_LAS unsigned char* sb = nullptr) const {
        unsigned char* ws = kargs_fresh()->ws; bf16_t* Q = (bf16_t*)(ws + WS_Q); constexpr size_t region_stride = (size_t)M * 512; const float* rope = (const float*)(ws + WS_ROPE);
        constexpr float qscale = QSCALE; const float* rss = (const float*)(ws + WS_RSS2); const float* shw = (const float*)(ws + WS_SHWIN); constexpr int ldshw = NIN;
        const int row0 = u.pm * BM + wr * 64 + fr, region = u.pn >> 1, b = u.pm >> 4, bcol0 = u.pn * BM + wc * 32 + 8 * fq;
        bf16_t* base = Q + (size_t)region * region_stride;
        f32x4 sw[2][2]; float rr[8];
        if (SIDE) {
#pragma unroll
            for (int bj = 0; bj < 2; ++bj)
#pragma unroll
                for (int n = 0; n < 2; ++n) sw[bj][n] = *(const PG8_LAS f32x4*)(sb + 1024 + 4 * (bj * HALF + wc * 32 + 8 * fq + 4 * n));
#pragma unroll
            for (int g = 0; g < 8; ++g) rr[g] = *(const PG8_LAS float*)(sb + 4 * (wr * 64 + fr + (g >> 2) * HALF + (g & 3) * 16));
        } else {
#pragma unroll
        for (int bj = 0; bj < 2; ++bj)
#pragma unroll
            for (int n = 0; n < 2; ++n) sw[bj][n] = *(const f32x4*)(shw + (size_t)b * ldshw + bcol0 + bj * HALF + 4 * n);
#pragma unroll
        for (int g = 0; g < 8; ++g) rr[g] = rss[row0 + (g >> 2) * HALF + (g & 3) * 16];
        }
#pragma unroll
        for (int g = 0; g < 8; ++g) rr[g] = rs_of(rr[g]);
        if (u.pn < 4) {
            const float sc = (region == 0) ? qscale : 1.0f;
            const int col0 = (u.pn & 1) * 256 + wc * 64 + 8 * fq;
#ifndef ROPE_AHEAD
#define ROPE_AHEAD 1
#endif
            constexpr int RA = ROPE_AHEAD;
            f32x4 ring[RA + 1][4];
#pragma unroll
            for (int q = 0; q < RA; ++q) { const int rowq = row0 + (q >> 2) * HALF + (q & 3) * 16; const f32x4* rp = (const f32x4*)(rope + ((size_t)(rowq & 4095) * 32 + 8 * fq) * 2);
                ring[q][0] = rp[0]; ring[q][1] = rp[1]; ring[q][2] = rp[2]; ring[q][3] = rp[3]; }
#pragma unroll
            for (int g = 0; g < 8; ++g) { const int ai = g >> 2, m = g & 3, row = row0 + ai * HALF + m * 16;
                if (g + RA < 8) { const int gn = g + RA, row2 = row0 + (gn >> 2) * HALF + (gn & 3) * 16; const f32x4* rp = (const f32x4*)(rope + ((size_t)(row2 & 4095) * 32 + 8 * fq) * 2);
                    ring[gn % (RA + 1)][0] = rp[0]; ring[gn % (RA + 1)][1] = rp[1]; ring[gn % (RA + 1)][2] = rp[2]; ring[gn % (RA + 1)][3] = rp[3]; }
                const f32x4 r0 = ring[g % (RA + 1)][0], r1 = ring[g % (RA + 1)][1], r2 = ring[g % (RA + 1)][2], r3 = ring[g % (RA + 1)][3];
                const float r = rr[g];
                const f32x4 x10 = acc[ai][0][m][0] * r + sw[0][0], x11 = acc[ai][0][m][1] * r + sw[0][1], x20 = acc[ai][1][m][0] * r + sw[1][0], x21 = acc[ai][1][m][1] * r + sw[1][1];
                u32x4 w1, w2;
                w1.x = cvt_pk_bf16((x10[0] * r0[0] - x20[0] * r0[1]) * sc, (x10[1] * r0[2] - x20[1] * r0[3]) * sc); w1.y = cvt_pk_bf16((x10[2] * r1[0] - x20[2] * r1[1]) * sc, (x10[3] * r1[2] - x20[3] * r1[3]) * sc);
                w1.z = cvt_pk_bf16((x11[0] * r2[0] - x21[0] * r2[1]) * sc, (x11[1] * r2[2] - x21[1] * r2[3]) * sc); w1.w = cvt_pk_bf16((x11[2] * r3[0] - x21[2] * r3[1]) * sc, (x11[3] * r3[2] - x21[3] * r3[3]) * sc);
                w2.x = cvt_pk_bf16((x20[0] * r0[0] + x10[0] * r0[1]) * sc, (x20[1] * r0[2] + x10[1] * r0[3]) * sc); w2.y = cvt_pk_bf16((x20[2] * r1[0] + x10[2] * r1[1]) * sc, (x20[3] * r1[2] + x10[3] * r1[3]) * sc);
                w2.z = cvt_pk_bf16((x21[0] * r2[0] + x11[0] * r2[1]) * sc, (x21[1] * r2[2] + x11[1] * r2[3]) * sc); w2.w = cvt_pk_bf16((x21[2] * r3[0] + x11[2] * r3[1]) * sc, (x21[3] * r3[2] + x11[3] * r3[3]) * sc);
                bf16_t* rowp = base + (size_t)row * 512 + col0;
                st16(rowp, w1); st16(rowp + 32, w2); }
        } else {
            const int col0 = (u.pn & 1) * 256 + wc * 32 + 8 * fq;
#pragma unroll
            for (int ai = 0; ai < 2; ++ai)
#pragma unroll
                for (int m = 0; m < 4; ++m) { bf16_t* rowp = base + (size_t)(row0 + ai * HALF + m * 16) * 512 + col0; const float r = rr[ai * 4 + m];
#pragma unroll
                    for (int bj = 0; bj < 2; ++bj) { const f32x4 v0 = acc[ai][bj][m][0] * r + sw[bj][0], v1 = acc[ai][bj][m][1] * r + sw[bj][1]; u32x4 w; w.x = cvt_pk_bf16(v0[0], v0[1]); w.y = cvt_pk_bf16(v0[2], v0[3]); w.z = cvt_pk_bf16(v1[0], v1[1]); w.w = cvt_pk_bf16(v1[2], v1[3]);
                        st16(rowp + bj * HALF, w); } }
        }
    }
};
template <int IMM> __device__ __forceinline__ void glds16s(const void* sbase, unsigned voff, unsigned lds_base) { unsigned keep;
    asm volatile("s_nop 4\n\ts_mov_b32 %0, m0\n\ts_add_u32 m0, %3, %4\n\ts_nop 0\n\tglobal_load_lds_dwordx4 %1, %2\n\ts_mov_b32 m0, %0" : "=&s"(keep) : "v"(voff), "s"(sbase), "s"(lds_base), "n"(IMM) : "memory", "scc"); }
template <class Epi, class Sched, bool ALIGN_EPI = false, bool SP2 = false, int ABL = 0, bool AG32 = false>
__device__ __forceinline__ void gemm_phase(PG8_LAS unsigned char* lds, const Gemm g, const Sched& S, const Epi& E, const int wave_id) {
    const int lane = ::mk_lane(), wid = wave_id, tid = wid * 64 + lane, wr = wid >> 2, wc = wid & 3, fr = lane & 15, fq = lane >> 4;
    const int K = g.K, nt = K / BK;
    unsigned voffA[2], voffB[2];
#pragma unroll
    for (int i = 0; i < 2; ++i) { int R, C; stage_rc(tid * 16 + i * 8192, R, C); const int Rb = Epi::PERM ? ((R & ~31) + perm32(R & 31)) : R;
        voffA[i] = AG32 ? (unsigned)((C >> 5) * BM * 32 + R * 32 + (C & 31)) * 2u : (unsigned)(R * K + C) * 2u; voffB[i] = (unsigned)(Rb * K + C) * 2u; }
    const size_t kstep = (size_t)(BK * 2);
    const size_t hstep = (size_t)HALF * K * 2;
    const size_t tstep = 2 * hstep;
    const size_t kstepA = AG32 ? (size_t)2 * BM * 32 * 2 : kstep, hstepA = AG32 ? (size_t)HALF * 32 * 2 : hstep, tstepA = tstep;
    const unsigned ldsw = (unsigned)wid * 1024u;
    const unsigned ldsd = (unsigned)__builtin_amdgcn_readfirstlane((int)((unsigned)(uintptr_t)lds + ldsw));
    const int aoff = lds_byte(wr * 64 + fr, fq * 8), boff = lds_byte(wc * 32 + fr, fq * 8);
#define PG8_SA(b, h) (((b) * 2 + (h)) * HTB)
#define PG8_SB(b, h) ((4 + (b) * 2 + (h)) * HTB)
#ifdef STAGE_BUILTIN
#define PG8_STAGE(bufoff, gbase, voff) do { if (ABL != 1) _Pragma("unroll") for (int _i = 0; _i < 2; ++_i) \
        __builtin_amdgcn_global_load_lds((const unsigned*)((const char*)(gbase) + (voff)[_i]), (PG8_LAS unsigned*)(lds + (bufoff) + ldsw + _i * 8192), 16, 0, 0); } while (0)
#else
#define PG8_STAGE(bufoff, gbase, voff) do { if (ABL != 1) { glds16s<(bufoff)>((const void*)(gbase), (voff)[0], ldsd); glds16s<(bufoff) + 8192>((const void*)(gbase), (voff)[1], ldsd); } } while (0)
#endif
#define PG8_LDA(dst, b, h) do { if (ABL != 2) _Pragma("unroll") for (int m = 0; m < 4; ++m) _Pragma("unroll") for (int k = 0; k < 2; ++k) dst[m][k] = *(const PG8_LAS bf16x8*)(lds + PG8_SA(b, h) + aoff + m * 2048 + k * 1024); } while (0)
#define PG8_LDB(dst, b, h) do { if (ABL != 2) _Pragma("unroll") for (int n = 0; n < 2; ++n) _Pragma("unroll") for (int k = 0; k < 2; ++k) dst[n][k] = *(const PG8_LAS bf16x8*)(lds + PG8_SB(b, h) + boff + n * 2048 + k * 1024); } while (0)
#ifdef GEMM_STATIC_PRIO
#define PG8_PRIO_UP() do {} while (0)
#define PG8_PRIO_DN() do {} while (0)
#else
#define PG8_PRIO_UP() __builtin_amdgcn_s_setprio(1)
#define PG8_PRIO_DN() __builtin_amdgcn_s_setprio(0)
#endif
#ifdef MMA_K_OUTER
#define PG8_MMA(ai, bj, At, Bt) do { PG8_PRIO_UP(); _Pragma("unroll") for (int k = 0; k < 2; ++k) _Pragma("unroll") for (int m = 0; m < 4; ++m) _Pragma("unroll") for (int n = 0; n < 2; ++n) \
        acc[ai][bj][m][n] = mma16(Bt[n][k], At[m][k], acc[ai][bj][m][n]); PG8_PRIO_DN(); } while (0)
#else
#define PG8_MMA(ai, bj, At, Bt) do { PG8_PRIO_UP(); _Pragma("unroll") for (int m = 0; m < 4; ++m) _Pragma("unroll") for (int n = 0; n < 2; ++n) _Pragma("unroll") for (int k = 0; k < 2; ++k) \
        acc[ai][bj][m][n] = mma16(Bt[n][k], At[m][k], acc[ai][bj][m][n]); PG8_PRIO_DN(); } while (0)
#endif
#ifdef MMA_EARLY_BAR
#define PG8_MMA2B(ai, At, B0, B1) do { PG8_MMA(ai, 0, At, B0); \
        PG8_PRIO_UP(); _Pragma("unroll") for (int m = 0; m < 3; ++m) _Pragma("unroll") for (int n = 0; n < 2; ++n) _Pragma("unroll") for (int k = 0; k < 2; ++k) acc[ai][1][m][n] = mma16(B1[n][k], At[m][k], acc[ai][1][m][n]); \
        PG8_SCHED; PG8_BAR; PG8_SCHED; __builtin_amdgcn_s_setprio(2); \
        _Pragma("unroll") for (int n = 0; n < 2; ++n) _Pragma("unroll") for (int k = 0; k < 2; ++k) acc[ai][1][3][n] = mma16(B1[n][k], At[3][k], acc[ai][1][3][n]); \
        PG8_PRIO_DN(); PG8_SCHED; } while (0)
#else
#define PG8_MMA2B(ai, At, B0, B1) do { PG8_MMA(ai, 0, At, B0); PG8_MMA(ai, 1, At, B1); PG8_BAR; PG8_SCHED; } while (0)
#endif
#define PG8_MMAZ(ai, bj, At, Bt) do { PG8_PRIO_UP(); _Pragma("unroll") for (int m = 0; m < 4; ++m) _Pragma("unroll") for (int n = 0; n < 2; ++n) { \
        acc[ai][bj][m][n] = mma16(Bt[n][0], At[m][0], (acc_t){0, 0, 0, 0}); acc[ai][bj][m][n] = mma16(Bt[n][1], At[m][1], acc[ai][bj][m][n]); } PG8_PRIO_DN(); } while (0)
#define PG8_WAIT_V(n) asm volatile("s_waitcnt vmcnt(" #n ")" ::: "memory")
#define PG8_WAIT_L(n) asm volatile("s_waitcnt lgkmcnt(" #n ")" ::: "memory")
#define PG8_BAR do { if (ABL != 3) __builtin_amdgcn_s_barrier(); } while (0)
#define PG8_SCHED __builtin_amdgcn_sched_barrier(0)
#ifdef GEMM_STATIC_PRIO
    if (wr == 1) __builtin_amdgcn_s_setprio(1);
#endif
    constexpr bool PEEL = SP2 && !ZeroByMov<Epi>::v;
    Unit cur, nxt; int ui = 0;
    if (!S.next(0, cur)) return;
#define PG8_SIDE(unit, par) do { if constexpr (Epi::SIDE) { int _l = ::mk_lane(); asm volatile("" : "+v"(_l)); \
        __builtin_amdgcn_global_load_lds((const unsigned*)(Epi::side_src(unit, wid) + _l * 4), (PG8_LAS unsigned*)(lds + SIDE_REL + (par) * 2048 + wid * 256), 4, 0, 0); } } while (0)
#define PG8_PREF(tt) do { if constexpr (Prefetch<Epi>::v) { int _l = ::mk_lane(); asm volatile("" : "+v"(_l)); unsigned _vo; const char* _sb = Epi::pref_src(cur, (tt), wid, _l, _vo); glds16s<STAGE_BYTES + 8192>((const void*)_sb, _vo, ldsd); } } while (0)
#define PG8_WAIT_S1 do { if constexpr (Prefetch<Epi>::v) PG8_WAIT_V(10); else PG8_WAIT_V(8); } while (0)
#define PG8_WAIT_S2 do { if constexpr (Prefetch<Epi>::v) PG8_WAIT_V(9); else PG8_WAIT_V(8); } while (0)
    PG8_SIDE(cur, 0);
    typedef typename AccOf<Epi>::type acc_t;
    acc_t acc[2][2][4][2];
    if constexpr (!PEEL) {
#pragma unroll
    for (int a = 0; a < 2; ++a)
#pragma unroll
        for (int b = 0; b < 2; ++b)
#pragma unroll
            for (int m = 0; m < 4; ++m)
#pragma unroll
                for (int n = 0; n < 2; ++n) acc[a][b][m][n] = (acc_t){0, 0, 0, 0};
    }
    bf16x8 At[4][2], B0[2][2], B1[2][2];
    if (ABL == 2) { _Pragma("unroll") for (int m = 0; m < 4; ++m) _Pragma("unroll") for (int k = 0; k < 2; ++k) { At[m][k] = (bf16x8){(short)(0x3f80 + lane), 1, 2, 3, 4, 5, 6, (short)(0x3c00 + m)}; asm volatile("" : "+v"(At[m][k])); }
        _Pragma("unroll") for (int n = 0; n < 2; ++n) _Pragma("unroll") for (int k = 0; k < 2; ++k) { B0[n][k] = (bf16x8){(short)(0x3e80 + lane), 7, 6, 5, 4, 3, 2, 1}; B1[n][k] = B0[n][k]; asm volatile("" : "+v"(B0[n][k]), "+v"(B1[n][k])); } }
    const char* cA = (const char*)g.A + (size_t)cur.pm * tstepA; const char* cB = (const char*)g.Bt + (size_t)cur.pn * tstep;
    S.a_ready(cur);
    if constexpr (SP2) {
        PG8_STAGE(PG8_SB(0, 0), cB, voffB); PG8_STAGE(PG8_SB(0, 1), cB + hstep, voffB); PG8_STAGE(PG8_SA(0, 0), cA, voffA); PG8_STAGE(PG8_SA(0, 1), cA + hstepA, voffA);
        if (wr == 1) PG8_BAR;
        PG8_WAIT_V(2); PG8_BAR;
        PG8_STAGE(PG8_SB(1, 0), cB + kstep, voffB); PG8_STAGE(PG8_SA(1, 0), cA + kstepA, voffA); PG8_STAGE(PG8_SB(1, 1), cB + hstep + kstep, voffB);
        PG8_WAIT_V(6); PG8_BAR;
    } else {
        PG8_STAGE(PG8_SB(0, 0), cB, voffB); PG8_STAGE(PG8_SA(0, 0), cA, voffA); PG8_STAGE(PG8_SB(0, 1), cB + hstep, voffB); PG8_STAGE(PG8_SA(0, 1), cA + hstepA, voffA);
        if (wr == 1) PG8_BAR;
        PG8_WAIT_V(4); PG8_BAR;
        PG8_STAGE(PG8_SB(1, 0), cB + kstep, voffB); PG8_STAGE(PG8_SA(1, 0), cA + kstepA, voffA); PG8_STAGE(PG8_SB(1, 1), cB + hstep + kstep, voffB);
        PG8_WAIT_V(6); PG8_BAR;
    }
    for (;;) {
        const bool has_next = S.next(ui + 1, nxt);
        const char* nA = has_next ? (const char*)g.A + (size_t)nxt.pm * tstepA : cA; const char* nB = has_next ? (const char*)g.Bt + (size_t)nxt.pn * tstep : cB;
        if constexpr (SP2) {
          if constexpr (PEEL) { const int t = 0;
            const bool last = (t == nt - 2);
            const char* a1 = cA + (size_t)(t + 1) * kstepA;
            const char* a2 = last ? nA : cA + (size_t)(t + 2) * kstepA; const char* b2 = last ? nB : cB + (size_t)(t + 2) * kstep;
            const char* a3 = a2 + kstepA; const char* b3 = b2 + kstep;
            if (last && has_next) S.a_ready(nxt);
            PG8_LDB(B0, 0, 0); PG8_LDB(B1, 0, 1); PG8_SCHED; PG8_LDA(At, 0, 0); PG8_STAGE(PG8_SA(1, 1), a1 + hstepA, voffA); PG8_PREF(t);
            PG8_WAIT_S1; PG8_WAIT_L(0); PG8_BAR; PG8_MMAZ(0, 0, At, B0); PG8_MMAZ(0, 1, At, B1); PG8_BAR; PG8_SCHED;
            PG8_LDA(At, 0, 1); PG8_STAGE(PG8_SB(0, 0), b2, voffB); PG8_STAGE(PG8_SB(0, 1), b2 + hstep, voffB); PG8_STAGE(PG8_SA(0, 0), a2, voffA);
            PG8_WAIT_S2; PG8_WAIT_L(0); PG8_BAR; PG8_MMAZ(1, 0, At, B0); PG8_MMAZ(1, 1, At, B1); PG8_BAR; PG8_SCHED;
            PG8_LDB(B0, 1, 0); PG8_LDB(B1, 1, 1); PG8_SCHED; PG8_LDA(At, 1, 0); PG8_STAGE(PG8_SA(0, 1), a2 + hstepA, voffA); PG8_PREF(t + 1);
            PG8_WAIT_S1; PG8_WAIT_L(0); PG8_BAR; PG8_MMA2B(0, At, B0, B1);
            PG8_LDA(At, 1, 1); PG8_STAGE(PG8_SB(1, 0), b3, voffB); PG8_STAGE(PG8_SB(1, 1), b3 + hstep, voffB); PG8_STAGE(PG8_SA(1, 0), a3, voffA);
            PG8_WAIT_S2; PG8_WAIT_L(0); PG8_BAR; PG8_MMA2B(1, At, B0, B1);
          }
          for (int t = PEEL ? 2 : 0; t < nt; t += 2) {
            const bool last = (t == nt - 2);
            const char* a1 = cA + (size_t)(t + 1) * kstepA;
            const char* a2 = last ? nA : cA + (size_t)(t + 2) * kstepA; const char* b2 = last ? nB : cB + (size_t)(t + 2) * kstep;
            const char* a3 = a2 + kstepA; const char* b3 = b2 + kstep;
            if (last && has_next) S.a_ready(nxt);
            PG8_LDB(B0, 0, 0); PG8_LDB(B1, 0, 1); PG8_SCHED; PG8_LDA(At, 0, 0); PG8_STAGE(PG8_SA(1, 1), a1 + hstepA, voffA); PG8_PREF(t);
            PG8_WAIT_S1; PG8_WAIT_L(0); PG8_BAR; PG8_MMA2B(0, At, B0, B1);
            PG8_LDA(At, 0, 1); PG8_STAGE(PG8_SB(0, 0), b2, voffB); PG8_STAGE(PG8_SB(0, 1), b2 + hstep, voffB); PG8_STAGE(PG8_SA(0, 0), a2, voffA);
            PG8_WAIT_S2; PG8_WAIT_L(0); PG8_BAR; PG8_MMA2B(1, At, B0, B1);
            PG8_LDB(B0, 1, 0); PG8_LDB(B1, 1, 1); PG8_SCHED; PG8_LDA(At, 1, 0); PG8_STAGE(PG8_SA(0, 1), a2 + hstepA, voffA); PG8_PREF(t + 1);
            PG8_WAIT_S1; PG8_WAIT_L(0); PG8_BAR; PG8_MMA2B(0, At, B0, B1);
            PG8_LDA(At, 1, 1); PG8_STAGE(PG8_SB(1, 0), b3, voffB); PG8_STAGE(PG8_SB(1, 1), b3 + hstep, voffB); PG8_STAGE(PG8_SA(1, 0), a3, voffA);
            PG8_WAIT_S2; PG8_WAIT_L(0); PG8_BAR; PG8_MMA2B(1, At, B0, B1);
          }
        } else {
        for (int t = 0; t < nt; t += 2) {
            const bool last = (t == nt - 2);
            const char* a1 = cA + (size_t)(t + 1) * kstepA;
            const char* a2 = last ? nA : cA + (size_t)(t + 2) * kstepA; const char* b2 = last ? nB : cB + (size_t)(t + 2) * kstep;
            const char* a3 = a2 + kstepA; const char* b3 = b2 + kstep;
            if (last && has_next) S.a_ready(nxt);
            PG8_LDB(B0, 0, 0); PG8_SCHED; PG8_LDA(At, 0, 0); PG8_STAGE(PG8_SA(1, 1), a1 + hstepA, voffA);
            PG8_WAIT_L(8); PG8_BAR; PG8_WAIT_L(0); PG8_MMA(0, 0, At, B0); PG8_BAR; PG8_SCHED;
            PG8_LDB(B1, 0, 1); PG8_STAGE(PG8_SB(0, 0), b2, voffB);
            PG8_BAR; PG8_WAIT_L(0); PG8_MMA(0, 1, At, B1); PG8_BAR;
            PG8_LDA(At, 0, 1); PG8_STAGE(PG8_SA(0, 0), a2, voffA);
            PG8_BAR; PG8_WAIT_L(0); PG8_MMA(1, 0, At, B0); PG8_BAR; PG8_SCHED;
            PG8_STAGE(PG8_SB(0, 1), b2 + hstep, voffB);
            PG8_WAIT_V(6); PG8_BAR; PG8_MMA(1, 1, At, B1); PG8_BAR;
            PG8_LDB(B0, 1, 0); PG8_SCHED; PG8_LDA(At, 1, 0); PG8_STAGE(PG8_SA(0, 1), a2 + hstepA, voffA);
            PG8_WAIT_L(8); PG8_BAR; PG8_WAIT_L(0); PG8_MMA(0, 0, At, B0); PG8_BAR; PG8_SCHED;
            PG8_LDB(B1, 1, 1); PG8_STAGE(PG8_SB(1, 0), b3, voffB);
            PG8_BAR; PG8_WAIT_L(0); PG8_MMA(0, 1, At, B1); PG8_BAR;
            PG8_LDA(At, 1, 1); PG8_STAGE(PG8_SA(1, 0), a3, voffA);
            PG8_BAR; PG8_WAIT_L(0); PG8_MMA(1, 0, At, B0); PG8_BAR; PG8_SCHED;
            PG8_STAGE(PG8_SB(1, 1), b3 + hstep, voffB);
            PG8_WAIT_V(6); PG8_BAR; PG8_MMA(1, 1, At, B1); PG8_BAR;
        }
        }
        if constexpr (ALIGN_EPI) { if (wr == 0) PG8_BAR; }
        if constexpr (!Epi::AFTER_DRAIN) { int l2 = ::mk_lane(); asm volatile("" : "+v"(l2)); if constexpr (Epi::SIDE) E(acc, cur, wr, wc, l2 & 15, l2 >> 4, lds + SIDE_REL + (ui & 1) * 2048); else E(acc, cur, wr, wc, l2 & 15, l2 >> 4); S.done(cur); }
        if (!has_next) break;
        if constexpr (!PEEL) {
#pragma unroll
        for (int a = 0; a < 2; ++a)
#pragma unroll
            for (int b = 0; b < 2; ++b)
#pragma unroll
                for (int m = 0; m < 4; ++m)
#pragma unroll
                    for (int n = 0; n < 2; ++n) acc[a][b][m][n] = (acc_t){0, 0, 0, 0};
        }
        cur = nxt; cA = nA; cB = nB; ++ui;
        PG8_SIDE(cur, ui & 1);
        if constexpr (ALIGN_EPI) { if (wr == 1) PG8_BAR; }
    }
#ifdef GEMM_STATIC_PRIO
    __builtin_amdgcn_s_setprio(0);
#endif
    PG8_WAIT_V(0);
    if constexpr (!ALIGN_EPI) { if (wr == 0) PG8_BAR; }
    PG8_BAR;
    if constexpr (Epi::AFTER_DRAIN) { E.fused(acc, cur, wr, wc, fr, fq, lds, wid, lane); S.done(cur); }
#undef PG8_SIDE
#undef PG8_PREF
#undef PG8_WAIT_S1
#undef PG8_WAIT_S2
#undef PG8_SA
#undef PG8_SB
#undef PG8_STAGE
#undef PG8_LDA
#undef PG8_LDB
#undef PG8_MMA
#undef PG8_MMA2B
#undef PG8_PRIO_UP
#undef PG8_PRIO_DN
#undef PG8_MMAZ
#undef PG8_WAIT_V
#undef PG8_WAIT_L
#undef PG8_BAR
#undef PG8_SCHED
}
}
namespace attn128 {
using bf16=unsigned short;
using bf16x8=__attribute__((ext_vector_type(8)))short;
using s16x4=__attribute__((ext_vector_type(4)))short;
using f32x16=__attribute__((ext_vector_type(16)))float;
using u32x4=__attribute__((ext_vector_type(4)))unsigned;
constexpr int BATCH=8,SEQ=4096,D=64,DV=128,DM=512,DMA=512,DMO=1024;
constexpr int NW=8,QBLK=32,QB=QBLK*NW,KVBLK=64,NQB=SEQ/QB;
constexpr int NSLOT=3,SLOTB=8192;
constexpr int LDS_K=0, LDS_V=NSLOT*SLOTB, LDS_WS=LDS_V+NSLOT*2*SLOTB, LDS_BYTES=LDS_WS+NW*64*4, LDS_OST=0;
static_assert(NW*8192<=LDS_WS,"O stage must stay below the f32 scratch");
__device__ __forceinline__ int crow(int r,int hi){return (r&3)+8*(r>>2)+4*hi;}
#define SBAR() __builtin_amdgcn_sched_barrier(0)
__device__ __forceinline__ void cmask(f32x16&p0,f32x16&p1,int jb,int qrel,int hi){
  const float NEG=-INFINITY; int kb=64*jb+4*hi;
  #pragma unroll
  for(int r=0;r<16;++r){int kv=kb+(r&3)+8*(r>>2); if(kv>qrel)p0[r]=NEG; if(kv+32>qrel)p1[r]=NEG;}
}
__device__ __forceinline__ void glds16(const void*sbase,unsigned voff,unsigned lds_dst){unsigned keep;
  asm volatile("s_nop 4\n\ts_mov_b32 %0, m0\n\ts_mov_b32 m0, %3\n\ts_nop 0\n\tglobal_load_lds_dwordx4 %1, %2\n\ts_mov_b32 m0, %0":"=&s"(keep):"v"(voff),"s"(sbase),"s"(lds_dst):"memory");}
typedef float f32x2_t __attribute__((ext_vector_type(2))); typedef __bf16 bf16x2_t __attribute__((ext_vector_type(2)));
__device__ __forceinline__ unsigned cvtpk_s(float lo,float hi){f32x2_t v={lo,hi};bf16x2_t b=__builtin_convertvector(v,bf16x2_t);return __builtin_bit_cast(unsigned,b);}
#define WAIT_BAR(N) do{ if(ABL==6) asm volatile("s_waitcnt vmcnt(" #N ") lgkmcnt(0)":::"memory"); else asm volatile("s_waitcnt vmcnt(" #N ") lgkmcnt(0)\n\ts_barrier":::"memory"); }while(0)
typedef __attribute__((address_space(3))) const char* lds_cptr;
typedef short v4i16_t __attribute__((ext_vector_type(4)));
__device__ __forceinline__ void kload2(bf16x8*kf,lds_cptr kp,int j){ kf[2*j]=*(const __attribute__((address_space(3))) bf16x8*)(kp+j*2048); kf[2*j+1]=*(const __attribute__((address_space(3))) bf16x8*)(kp+j*2048+512); }
__device__ __forceinline__ s16x4 vtr(lds_cptr p){ return __builtin_bit_cast(s16x4,__builtin_amdgcn_ds_read_tr16_b64_v4i16((__attribute__((address_space(3))) v4i16_t*)p)); }
#define MX3(a,b,c) __builtin_fmaxf(__builtin_fmaxf((a),(b)),(c))
__device__ __forceinline__ float rowmax(const f32x16&p0,const f32x16&p1){
  float a=MX3(p0[0],p0[1],p1[0]),b=MX3(p0[2],p0[3],p1[1]);a=MX3(a,p1[2],p1[3]);
  #pragma unroll
  for(int r=4;r<16;r+=4){a=MX3(a,p0[r],p0[r+1]);b=MX3(b,p0[r+2],p0[r+3]);a=MX3(a,p1[r],p1[r+1]);b=MX3(b,p1[r+2],p1[r+3]);}
  float m=__builtin_fmaxf(a,b);
  auto rr=__builtin_amdgcn_permlane32_swap(__float_as_uint(m),__float_as_uint(m),false,false);
  return __builtin_fmaxf(__uint_as_float(rr[0]),__uint_as_float(rr[1]));
}
#define MFMA32(a,b,c) __builtin_amdgcn_mfma_f32_32x32x16_bf16(a,b,c,0,0,0)

struct ConvArgs { const bf16* B; const bf16* C; const bf16* U; const float* w; const float* g; };
template<int THRL,bool COMBINE,int ABL=0> __device__ __forceinline__ void attn_unit(int b,int qcol,int vcol,int ocol,int qb,const bf16*Q,const bf16*__restrict__ K,const bf16*__restrict__ V,bf16*O,bf16*MIXO,const float*subln_g,const float lamv,const ConvArgs&CV,const int conv_r0,char*shm,const int wave_id){
  int lane_=::mk_lane(); asm volatile("":"+v"(lane_)); const int lane=lane_,r32=lane&31,hi=lane>>5; const int wid=wave_id;
  const long rowbase=(long)b*SEQ; const int q0=qb*QB;
  const bf16*Qw=Q+(rowbase+q0+wid*QBLK)*DM+qcol;
  const bf16*Kh=K+rowbase*DM+qcol,*Vh=V+rowbase*DM+vcol;
  const unsigned lds0=(unsigned)(uintptr_t)shm;
  float*wsf=(float*)(shm+LDS_WS)+wid*64;
  const unsigned koff=(unsigned)(lane*DM+wid*8)*2u;
  const unsigned voff=(unsigned)((16*(wid&3)+(lane>>2))*DM+(wid>>2)*32+(lane&3)*8)*2u;
  const unsigned kdst=lds0+LDS_K+wid*1024, vdst=lds0+LDS_V+wid*1024;
  #define DMA_K(t,slot) glds16(Kh+(long)(t)*KVBLK*DM,koff,(unsigned)__builtin_amdgcn_readfirstlane(kdst+(slot)))
  #define DMA_V(t,slot) do{ if(ABL!=4){ glds16(Vh+(long)(t)*KVBLK*DM,voff,(unsigned)__builtin_amdgcn_readfirstlane(vdst+2*(slot))); glds16(Vh+(long)(t)*KVBLK*DM+64,voff,(unsigned)__builtin_amdgcn_readfirstlane(vdst+2*(slot)+8192)); } }while(0)
  bf16x8 kf[8];
  const lds_cptr shm3=(lds_cptr)shm; const lds_cptr kp0=shm3+LDS_K+hi*1024+r32*16; const lds_cptr vp0=shm3+LDS_V+((lane>>4)&1)*32+(lane&3)*8+(4*hi+((lane&15)>>2))*64;
  const int NT=(q0+QB)/KVBLK;
  DMA_K(0,0);DMA_V(0,0);DMA_K(1,SLOTB);
  bf16x8 qr[4];
  #pragma unroll
  for(int d0=0;d0<4;++d0)qr[d0]=*reinterpret_cast<const bf16x8*>(&Qw[(long)r32*DM+d0*16+hi*8]);
  float mhat=0.f,l_reg=0.f;f32x16 o[4];o[0]=f32x16{};o[1]=f32x16{};o[2]=f32x16{};o[3]=f32x16{};
  const int qrel=wid*QBLK+r32;
  bool resc=false;
  #define RESC() do{ if(resc){ asm volatile("s_waitcnt lgkmcnt(0)":::"memory"); \
      _Pragma("unroll") for(int r=0;r<16;++r){ const float f_=wsf[crow(r,hi)]; o[0][r]*=f_; o[1][r]*=f_; o[2][r]*=f_; o[3][r]*=f_; } } }while(0)
  f32x16 c0,c1; s16x4 vlo[8],vhi[8]; u32x4 pp0,pp1,pp2,pp3,pc0,pc1,pc2,pc3;
  int sl_prev=0,sl_cur=0,sl_next=SLOTB;
  #define ROT() do{sl_prev=sl_cur;sl_cur=sl_next;sl_next=(sl_next==(NSLOT-1)*SLOTB)?0:sl_next+SLOTB;}while(0)
  #define EX(v) (ABL==1?(v):__builtin_amdgcn_exp2f(v))
  #define PIN(x) asm volatile("":"+v"(x))
  #define FRAG(j) ((((j)&3)<<2)|((j)>>2))
  #define VRDS(s,f) do{ if(ABL!=2){ vlo[s]=vtr(vp_+(((f)>>2)*4096+((f)&3)*1024)); vhi[s]=vtr(vp_+(((f)>>2)*4096+((f)&3)*1024+512)); } }while(0)
  #define VFS(s) (bf16x8){vlo[s][0],vlo[s][1],vlo[s][2],vlo[s][3],vhi[s][0],vhi[s][1],vhi[s][2],vhi[s][3]}
  #define SM2N(PC,W,X,B) do{ const float a_=EX(X[B]+nmh), b_=EX(X[(B)+1]+nmh); sacc+=a_; sacc+=b_; PC[W]=cvtpk_s(a_,b_); }while(0)
#ifdef NEGM_MFMA
  #define SM2(PC,W,X,B) do{ const float a_=EX(X[B]), b_=EX(X[(B)+1]); sacc+=a_; sacc+=b_; PC[W]=cvtpk_s(a_,b_); }while(0)
  #define CINIT() __builtin_amdgcn_mfma_f32_32x32x2f32(one_,nmb,f32x16{},0,0,0)
#else
  #define SM2(PC,W,X,B) SM2N(PC,W,X,B)
  #define CINIT() f32x16{}
#endif
  DMA_K(2,2*SLOTB);
  WAIT_BAR(4);
  { _Pragma("unroll") for(int j=0;j<4;++j)kload2(kf,kp0,j);
    c0=MFMA32(kf[0],qr[0],f32x16{}); c1=MFMA32(kf[1],qr[0],f32x16{}); c0=MFMA32(kf[2],qr[1],c0); c1=MFMA32(kf[3],qr[1],c1);
    c0=MFMA32(kf[4],qr[2],c0); c1=MFMA32(kf[5],qr[2],c1); c0=MFMA32(kf[6],qr[3],c0); c1=MFMA32(kf[7],qr[3],c1);
    if(NT==4)cmask(c0,c1,0,qrel,hi);
    mhat=rowmax(c0,c1); const float nmh=-mhat; float sacc=0.f;
    SM2N(pp0,0,c0,0);SM2N(pp0,1,c0,2);SM2N(pp0,2,c0,4);SM2N(pp0,3,c0,6);SM2N(pp1,0,c0,8);SM2N(pp1,1,c0,10);SM2N(pp1,2,c0,12);SM2N(pp1,3,c0,14);
    SM2N(pp2,0,c1,0);SM2N(pp2,1,c1,2);SM2N(pp2,2,c1,4);SM2N(pp2,3,c1,6);SM2N(pp3,0,c1,8);SM2N(pp3,1,c1,10);SM2N(pp3,2,c1,12);SM2N(pp3,3,c1,14);
    l_reg=sacc; }
#ifdef NEGM_MFMA
  float nmb=-0.5f*mhat;
#endif
  WAIT_BAR(0);
  DMA_K(3,0);DMA_V(1,SLOTB);
  ROT();
  _Pragma("unroll") for(int j=0;j<4;++j)kload2(kf,kp0+sl_cur,j);
  WAIT_BAR(3);
#ifndef ATTN_KL0
#define ATTN_KL0 3
#endif
  constexpr int KL0=ATTN_KL0;
  #define GAPB(J,PP,PC,W,X,B,GL) do{ if(ABL!=5) o[(J)&3]=MFMA32(__builtin_bit_cast(bf16x8,PP),VFS((J)&7),o[(J)&3]); SM2(PC,W,X,B); PIN(sacc); PIN(PC); \
      if((J)<8){ VRDS((J)&7,FRAG(((J)&7)+8)); } if((GL)&&(J)>=KL0&&(J)<=KL0+3){ kload2(kf,kp0+sl_next,(J)-KL0); } SBAR(); }while(0)
  #define PVM(J,PP,GL) do{ if(ABL!=5) o[(J)&3]=MFMA32(__builtin_bit_cast(bf16x8,PP),VFS((J)&7),o[(J)&3]); \
      if((J)<8){ VRDS((J)&7,FRAG(((J)&7)+8)); } if((GL)&&(J)>=KL0&&(J)<=KL0+3){ kload2(kf,kp0+sl_next,(J)-KL0); } SBAR(); }while(0)
  #define SMO(PC,W,X,B) do{ SM2(PC,W,X,B); PIN(sacc); PIN(PC); SBAR(); }while(0)
#ifdef NEGM_MFMA
  #define RMREL(rm) (rm)
  #define MUPD(dl) do{ nmb-=0.5f*(dl); c0-=(dl); c1-=(dl); }while(0)
  #define NMH_DECL
  #define ONE_DECL float one_=1.0f; asm volatile("":"+v"(one_))
#else
  #define ONE_DECL
  #define RMREL(rm) ((rm)-mhat)
  #define MUPD(dl) do{ mhat+=(dl); }while(0)
  #define NMH_DECL const float nmh=-mhat
#endif
#ifdef SM_PIPE
  #define SME(J,EA,EB) do{ EA=EX(((J)<8?c0:c1)[2*((J)&7)]+nmh); EB=EX(((J)<8?c0:c1)[2*((J)&7)+1]+nmh); }while(0)
  #define G2(J,PP,PC,W,EAJ,EBJ,EAN,EBN,GL) do{ if(ABL!=5) o[(J)&3]=MFMA32(__builtin_bit_cast(bf16x8,PP),VFS((J)&7),o[(J)&3]); \
      if((J)<15){ SME((J)+1,EAN,EBN); } sacc+=EAJ; sacc+=EBJ; PC[W]=cvtpk_s(EAJ,EBJ); PIN(sacc); PIN(PC); \
      if((J)<8){ VRDS((J)&7,FRAG(((J)&7)+8)); } if((GL)&&(J)>=KL0&&(J)<=KL0+3){ kload2(kf,kp0+sl_next,(J)-KL0); } SBAR(); }while(0)
  #define PHASEB(PA0,PA1,PA2,PA3,PB0,PB1,PB2,PB3,GL) do{ float ea0,eb0,ea1,eb1; SME(0,ea0,eb0); \
      G2(0,PA0,PB0,0,ea0,eb0,ea1,eb1,GL); G2(1,PA0,PB0,1,ea1,eb1,ea0,eb0,GL); G2(2,PA0,PB0,2,ea0,eb0,ea1,eb1,GL); G2(3,PA0,PB0,3,ea1,eb1,ea0,eb0,GL); \
      G2(4,PA1,PB1,0,ea0,eb0,ea1,eb1,GL); G2(5,PA1,PB1,1,ea1,eb1,ea0,eb0,GL); G2(6,PA1,PB1,2,ea0,eb0,ea1,eb1,GL); G2(7,PA1,PB1,3,ea1,eb1,ea0,eb0,GL); \
      G2(8,PA2,PB2,0,ea0,eb0,ea1,eb1,GL); G2(9,PA2,PB2,1,ea1,eb1,ea0,eb0,GL); G2(10,PA2,PB2,2,ea0,eb0,ea1,eb1,GL); G2(11,PA2,PB2,3,ea1,eb1,ea0,eb0,GL); \
      G2(12,PA3,PB3,0,ea0,eb0,ea1,eb1,GL); G2(13,PA3,PB3,1,ea1,eb1,ea0,eb0,GL); G2(14,PA3,PB3,2,ea0,eb0,ea1,eb1,GL); G2(15,PA3,PB3,3,ea1,eb1,ea0,eb0,GL); }while(0)
#else
  #define PHASEB(PA0,PA1,PA2,PA3,PB0,PB1,PB2,PB3,GL) do{ PVFIRST(PA0,PB0,GL); \
      GAPB(4,PA1,PB1,0,c0,8,GL); GAPB(5,PA1,PB1,1,c0,10,GL); GAPB(6,PA1,PB1,2,c0,12,GL); GAPB(7,PA1,PB1,3,c0,14,GL); \
      GAPB(8,PA2,PB2,0,c1,0,GL); GAPB(9,PA2,PB2,1,c1,2,GL); GAPB(10,PA2,PB2,2,c1,4,GL); GAPB(11,PA2,PB2,3,c1,6,GL); \
      GAPB(12,PA3,PB3,0,c1,8,GL); GAPB(13,PA3,PB3,1,c1,10,GL); GAPB(14,PA3,PB3,2,c1,12,GL); GAPB(15,PA3,PB3,3,c1,14,GL); }while(0)
#endif
#ifdef PV_HEAD
  #define PVHEAD(PA0,GL) do{ PVM(0,PA0,GL); PVM(1,PA0,GL); PVM(2,PA0,GL); PVM(3,PA0,GL); }while(0)
  #define PVFIRST(PA0,PB0,GL) do{ SMO(PB0,0,c0,0); SMO(PB0,1,c0,2); SMO(PB0,2,c0,4); SMO(PB0,3,c0,6); }while(0)
#else
  #define PVHEAD(PA0,GL) do{}while(0)
  #define PVFIRST(PA0,PB0,GL) do{ GAPB(0,PA0,PB0,0,c0,0,GL); GAPB(1,PA0,PB0,1,c0,2,GL); GAPB(2,PA0,PB0,2,c0,4,GL); GAPB(3,PA0,PB0,3,c0,6,GL); }while(0)
#endif
  #define STEPX(t,MASK,GK,GV,GL,PA0,PA1,PA2,PA3,PB0,PB1,PB2,PB3) do{ SBAR(); ONE_DECL; \
    const lds_cptr vp_=vp0+2*sl_prev; \
    VRDS(0,FRAG(0)); SBAR(); c0=MFMA32(kf[0],qr[0],CINIT()); SBAR(); \
    VRDS(1,FRAG(1)); SBAR(); c1=MFMA32(kf[1],qr[0],CINIT()); SBAR(); \
    VRDS(2,FRAG(2)); SBAR(); c0=MFMA32(kf[2],qr[1],c0); SBAR(); \
    VRDS(3,FRAG(3)); SBAR(); c1=MFMA32(kf[3],qr[1],c1); SBAR(); \
    VRDS(4,FRAG(4)); SBAR(); c0=MFMA32(kf[4],qr[2],c0); SBAR(); \
    VRDS(5,FRAG(5)); SBAR(); c1=MFMA32(kf[5],qr[2],c1); SBAR(); \
    VRDS(6,FRAG(6)); SBAR(); c0=MFMA32(kf[6],qr[3],c0); SBAR(); \
    VRDS(7,FRAG(7)); SBAR(); c1=MFMA32(kf[7],qr[3],c1); SBAR(); \
    if(GK){DMA_K((t)+3,sl_cur);} if(GV){DMA_V((t)+1,sl_next);} \
    if(MASK){ const int jb_=(t)-(NT-4); if(jb_>=0)cmask(c0,c1,jb_,qrel,hi); } \
    PVHEAD(PA0,GL); \
    { const float rm=(ABL==7)?mhat:rowmax(c0,c1); resc=false; \
      if(__builtin_expect(__any(RMREL(rm)>(float)THRL),0)){ const float dl=__builtin_fmaxf(RMREL(rm),0.f); MUPD(dl); \
        const float f=__builtin_amdgcn_exp2f(-dl); l_reg*=f; { int l_=::mk_lane(); asm volatile("":"+v"(l_)); if(l_<32)wsf[l_]=f; } resc=true; } } \
    SBAR(); \
    { NMH_DECL; float sacc=0.f; \
      PHASEB(PA0,PA1,PA2,PA3,PB0,PB1,PB2,PB3,GL); \
      l_reg+=sacc; } \
    }while(0)
  #define STEP(t,MASK,GK,GV,GL) do{ STEPX(t,MASK,GK,GV,GL,pp0,pp1,pp2,pp3,pc0,pc1,pc2,pc3); pp0=pc0;pp1=pc1;pp2=pc2;pp3=pc3; }while(0)
  int t=1;
#ifndef NO_STEP_PAIR
#if defined(ATTN_PRIO) && ATTN_PRIO == 2
  for(;t+5<NT;t+=2){ if(wid>=4)__builtin_amdgcn_s_setprio(1); STEPX(t,false,true,true,true,pp0,pp1,pp2,pp3,pc0,pc1,pc2,pc3); WAIT_BAR(3); RESC(); ROT();
                     if(wid>=4)__builtin_amdgcn_s_setprio(0); STEPX(t+1,false,true,true,true,pc0,pc1,pc2,pc3,pp0,pp1,pp2,pp3); WAIT_BAR(3); RESC(); ROT(); }
#else
#ifdef ATTN_SKEW
  #define SKEW() do{ if(wid<4)__builtin_amdgcn_s_sleep(ATTN_SKEW); }while(0)
#else
  #define SKEW() do{}while(0)
#endif
  for(;t+5<NT;t+=2){ SKEW(); STEPX(t,false,true,true,true,pp0,pp1,pp2,pp3,pc0,pc1,pc2,pc3); WAIT_BAR(3); RESC(); ROT();
                     SKEW(); STEPX(t+1,false,true,true,true,pc0,pc1,pc2,pc3,pp0,pp1,pp2,pp3); WAIT_BAR(3); RESC(); ROT(); }
#endif
#endif
  for(;t+4<NT;++t){ STEP(t,false,true,true,true); WAIT_BAR(3); RESC(); ROT(); }
  #define ENDW(tt) do{ if((tt)+3<NT){WAIT_BAR(3);} else if((tt)+2<NT){WAIT_BAR(2);} else {WAIT_BAR(0);} }while(0)
  const int lastlive=wid>>1;
  #define DEADSTEP(t,GK,GV,PVLIVE) do{ if(GK){DMA_K((t)+3,sl_cur);} if(GV){DMA_V((t)+1,sl_next);} resc=false; \
    if(PVLIVE){ const lds_cptr vp_=vp0+2*sl_prev; _Pragma("unroll") for(int j=0;j<16;++j){ const int s_=j&7; VRDS(s_,FRAG(j)); asm volatile("s_waitcnt lgkmcnt(0)":::"memory"); SBAR(); \
        o[j&3]=MFMA32(__builtin_bit_cast(bf16x8,(j>>2)==0?pp0:(j>>2)==1?pp1:(j>>2)==2?pp2:pp3),VFS(s_),o[j&3]); } } }while(0)
  const int tl=NT-4+lastlive;
  for(;t+1<NT&&t<=tl;++t){ STEP(t,true,(t+3<NT),(t+1<NT),((t+1<NT)&&(t<tl))); ENDW(t); RESC(); ROT(); }
  if(lastlive>=3){
    STEP(NT-1,true,false,false,false); RESC();
    const lds_cptr vp_=vp0+2*sl_cur;
    #pragma unroll
    for(int j=0;j<16;++j){ const int s=j&7; VRDS(s,FRAG(j)); asm volatile("s_waitcnt lgkmcnt(0)":::"memory"); SBAR();
      o[j&3]=MFMA32(__builtin_bit_cast(bf16x8,(j>>2)==0?pp0:(j>>2)==1?pp1:(j>>2)==2?pp2:pp3),VFS(s),o[j&3]); }
  } else {
    bool pv=true;
    for(;t<NT;++t){ DEADSTEP(t,(t+3<NT),(t+1<NT),pv); pv=false; if(t+1<NT){ ENDW(t); ROT(); } }
  }
  {auto rr=__builtin_amdgcn_permlane32_swap(__float_as_uint(l_reg),__float_as_uint(l_reg),false,false);l_reg=__uint_as_float(rr[0])+__uint_as_float(rr[1]);}
  { int le_=::mk_lane(); asm volatile("":"+v"(le_)); const int e32=le_&31,ehi=le_>>5;
    ::Conv4 cq; ::conv4_load(cq,CV.B,CV.C,CV.U,conv_r0,le_);
    if(ehi==0)wsf[32+e32]=l_reg;asm volatile("s_waitcnt lgkmcnt(0)":::"memory");
    float rli[16];
    #pragma unroll
    for(int r=0;r<16;++r)rli[r]=__builtin_amdgcn_rcpf(wsf[32+crow(r,ehi)]);
    asm volatile("s_waitcnt lgkmcnt(0)\n\ts_barrier":::"memory");
    bf16*Ow=O+(rowbase+q0+wid*QBLK)*DMA+ocol;
    u32x4 prev[8];
    if(COMBINE){
      #pragma unroll
      for(int i=0;i<8;++i){const int row=i*4+(le_>>4),ch=le_&15; prev[i]=*(const u32x4*)(Ow+(long)row*DMA+ch*8);} }
    bf16*stg=(bf16*)(shm+LDS_OST)+wid*4096;
    #pragma unroll
    for(int r=0;r<16;++r){const int orow=crow(r,ehi);
      #pragma unroll
      for(int d0=0;d0<4;++d0)stg[orow*128+d0*32+e32]=(bf16)::f2bf(o[d0][r]*rli[r]);}
    asm volatile("s_waitcnt lgkmcnt(0)":::"memory");
    if(!COMBINE){
      #pragma unroll
      for(int i=0;i<8;++i){const int row=i*4+(le_>>4),ch=le_&15; const u32x4 v=*(const u32x4*)(stg+row*128+ch*8); *(u32x4*)(Ow+(long)row*DMA+ch*8)=v;}
    } else {
      const int ch=le_&15; float sg[8];
      #pragma unroll
      for(int e=0;e<8;++e)sg[e]=subln_g[ch*8+e]*(1.0f-::LAMBDA_INIT);
      bf16*Mw=MIXO+(rowbase+q0+wid*QBLK)*DMO+ocol;
      #pragma unroll
      for(int i=0;i<8;++i){const int row=i*4+(le_>>4); const u32x4 v2=*(const u32x4*)(stg+row*128+ch*8); float a0[8],a1[8],oo[8];
        ::unpack8(prev[i],a0); ::unpack8(v2,a1); float ss=0.f;
        #pragma unroll
        for(int e=0;e<8;++e){oo[e]=a0[e]-lamv*a1[e]; ss+=oo[e]*oo[e];}
        ss+=__shfl_xor(ss,1); ss+=__shfl_xor(ss,2); ss+=__shfl_xor(ss,4); ss+=__shfl_xor(ss,8);
        const float ra=1.0f/sqrtf(ss*(1.f/128.f)+::SUBLN_EPS);
        #pragma unroll
        for(int e=0;e<8;++e)oo[e]=oo[e]*ra*sg[e];
        pg8::st16((void*)(Mw+(long)row*DMO+ch*8),::pack8(oo));} }
    ::conv4_finish(cq,MIXO,CV.w,CV.g,conv_r0,le_); }
  asm volatile("s_waitcnt lgkmcnt(0)\n\ts_barrier":::"memory");
  #undef DMA_K
  #undef DMA_V
  #undef RESC
  #undef ROT
  #undef EX
  #undef PIN
  #undef FRAG
  #undef VRDS
  #undef VFS
  #undef SM2
  #undef GAPB
  #undef STEP
  #undef STEPX
  #undef PHASEB
  #undef PVHEAD
  #undef PVFIRST
  #undef PVM
  #undef SMO
  #undef RMREL
  #undef MUPD
  #undef NMH_DECL
  #undef ONE_DECL
  #undef CINIT
  #undef SM2N
  #undef ENDW
  #undef DEADSTEP
}
constexpr int ATTN_LDS_BYTES=LDS_BYTES;
struct AttnTensors { const bf16* Q; const bf16* K; const bf16* V; bf16* AO; bf16* MIX; const float* subln_g; const float* lam; ConvArgs cv; };
struct AttnUnit { int b, h, c, qb; };
#ifndef ATTN_LONGFIRST
#define ATTN_LONGFIRST 0
#endif
struct StaticOrder {
  int vcu;
  __device__ __forceinline__ explicit StaticOrder(int grid,int block):vcu((block%8)*(grid/8)+block/8){}
#ifdef ATTN_ORDER2
  __device__ __forceinline__ bool next(int i,AttnUnit&u)const{ if(i>=4)return false; const int q=vcu&15,g=(vcu>>4)&1; u.b=vcu>>5; u.h=(i>>1)?2+g:g; u.c=i&1; u.qb=(i>>1)?15-q:q; return true; }
#else
  __device__ __forceinline__ bool next(int i,AttnUnit&u)const{ if(i>=4)return false; const int s=vcu&7; u.b=vcu>>5; u.h=(vcu>>3)&3; u.c=i&1; u.qb=((i>>1)^ATTN_LONGFIRST)?15-s:s; return true; }
#endif
};
#ifndef ATTN_THRL
#define ATTN_THRL 8
#endif
template<class Sched,int THRL=ATTN_THRL,int ABL=0> __device__ __forceinline__ void attn_phase(char*lds,const AttnTensors&T,const Sched&S,const int wave_id){
  AttnUnit u; const float lamv=*T.lam;
#if defined(ATTN_PRIO) && ATTN_PRIO == 3
  if(wave_id<4)__builtin_amdgcn_s_setprio(1);
#endif
#if defined(ATTN_PRIO) && ATTN_PRIO == 1
  if(wave_id>=4)__builtin_amdgcn_s_setprio(1);
#endif
  for(int i=0;S.next(i,u);++i){
    const int cr0=u.b*SEQ+(((S.vcu&31)*NW+wave_id)*4+i)*4;
    if(u.c==0) attn_unit<THRL,false,ABL>(u.b,(u.h*2)*64,u.h*128,u.h*128,u.qb,T.Q,T.K,T.V,T.AO,T.MIX,T.subln_g,lamv,T.cv,cr0,lds,wave_id);
    else       attn_unit<THRL,true,ABL>(u.b,(u.h*2+1)*64,u.h*128,u.h*128,u.qb,T.Q,T.K,T.V,T.AO,T.MIX,T.subln_g,lamv,T.cv,cr0,lds,wave_id); }
#ifdef ATTN_PRIO
  __builtin_amdgcn_s_setprio(0);
#endif
}
#undef SBAR
#undef WAIT_BAR
#undef MX3
#undef MFMA32
}
#define GAS __attribute__((address_space(1)))
#define LAS __attribute__((address_space(3)))
typedef GAS unsigned gu32;
typedef GAS unsigned long long gu64;
#define RLX_AGENT __ATOMIC_RELAXED, __HIP_MEMORY_SCOPE_AGENT
#define LDS_WAIT() asm volatile("s_waitcnt lgkmcnt(0)" ::: "memory")
#define VM_WAIT() asm volatile("s_waitcnt vmcnt(0)" ::: "memory")
__device__ __forceinline__ unsigned long long rt() { return __builtin_amdgcn_s_memrealtime(); }

#define XB_TMO      128
#define XB_XCNT(j)  (256  + 64 * (j))
#define XB_XSUB(j)  (1280 + 64 * (j))
#define XB_XGEN(j)  (2304 + 64 * (j))
#define XB_TOP      3328
#define XB_TOPGEN   3392
#define XCD_BAR_WORDS 3456
#define XB_SPIN_CAP (1u << 18)

__device__ __forceinline__ unsigned xb_ld(unsigned* p)              { return __hip_atomic_load(p, __ATOMIC_RELAXED, __HIP_MEMORY_SCOPE_AGENT); }
__device__ __forceinline__ unsigned xb_add(unsigned* p, unsigned v) { return __hip_atomic_fetch_add(p, v, __ATOMIC_RELAXED, __HIP_MEMORY_SCOPE_AGENT); }
#ifdef BAR_L2LOCAL
__device__ __forceinline__ unsigned xb_add_x(unsigned* p, unsigned v) { return __hip_atomic_fetch_add(p, v, __ATOMIC_RELAXED, __HIP_MEMORY_SCOPE_WORKGROUP); }
__device__ __forceinline__ unsigned xb_ld_x(unsigned* p)              { unsigned v; asm volatile("global_load_dword %0, %1, off nt\n\ts_waitcnt vmcnt(0)" : "=&v"(v) : "v"(p) : "memory"); return v; }
#else
__device__ __forceinline__ unsigned xb_add_x(unsigned* p, unsigned v) { return xb_add(p, v); }
__device__ __forceinline__ unsigned xb_ld_x(unsigned* p)              { return xb_ld(p); }
#endif
__device__ __forceinline__ unsigned xb_xcc_id() { return (unsigned)__builtin_amdgcn_s_getreg((3 << 11) | 20) & 0xFu; }
#define XB_SPIN(cond, bar) do { unsigned _sp = 0; while (cond) { __builtin_amdgcn_s_sleep(1); \
    if ((++_sp & 255u) == 0u) { if (xb_ld(&(bar)[XB_TMO])) break; if (_sp > XB_SPIN_CAP) { atomicAdd(&(bar)[XB_TMO], 1u); break; } } } } while (0)

struct XcdBarrier {
    unsigned* bar; unsigned x;
    volatile LAS unsigned* st; int wave;
};

__device__ __forceinline__ XcdBarrier xcd_barrier_post(unsigned* bar, volatile LAS unsigned* st) {
    XcdBarrier b; b.bar = bar; b.x = xb_xcc_id(); b.st = st;
    if (threadIdx.x == 0) (void)xb_add(&bar[XB_XCNT(b.x)], 1u);
    return b;
}
__device__ __forceinline__ void xcd_barrier_complete(unsigned* bar, unsigned x, unsigned& nloc, unsigned& nx) {
    const unsigned G = gridDim.x * gridDim.y * gridDim.z;
    unsigned sum, cnt, mine, sp = 0u;
    for (;;) {
        sum = 0u; cnt = 0u; mine = 0u;
#pragma unroll
        for (unsigned j = 0; j < 16; ++j) { const unsigned c = xb_ld(&bar[XB_XCNT(j)]); sum += c; cnt += (c > 0u) ? 1u : 0u; mine = (j == x) ? c : mine; }
        if (sum == G) break;
        __builtin_amdgcn_s_sleep(1);
        if ((++sp & 255u) == 0u) { if (xb_ld(&bar[XB_TMO])) break; if (sp > XB_SPIN_CAP) { atomicAdd(&bar[XB_TMO], 1u); break; } }
    }
    nloc = mine > 0u ? mine : 1u; nx = cnt > 0u ? cnt : 1u;
}

template <bool LOCAL = false>
__device__ __forceinline__ void xcd_barrier(const XcdBarrier& b) {
    asm volatile("s_waitcnt vmcnt(0)" ::: "memory");
    __syncthreads();
#ifdef BAR_EARLY_WB
    if (b.wave == 1) asm volatile("buffer_wbl2 sc1" ::: "memory");
#endif
    if (b.wave == 0 && ::mk_lane() == 0) {
        unsigned* bar = b.bar;
        __builtin_amdgcn_s_waitcnt(0);
        unsigned nloc = b.st[0], nx = b.st[1];
        if (nloc == 0u) { xcd_barrier_complete(bar, b.x, nloc, nx); b.st[0] = nloc; b.st[1] = nx; }
        const unsigned old = xb_add_x(&bar[XB_XSUB(b.x)], 1u);
        const unsigned gen = old / nloc;
        if (old + 1u == (gen + 1u) * nloc) {
            if (!LOCAL) __builtin_amdgcn_fence(__ATOMIC_RELEASE, "agent");
            asm volatile("s_waitcnt vmcnt(0)" ::: "memory");
            const unsigned og = xb_add(&bar[XB_TOP], 1u);
            const unsigned tg = og / nx;
            if (og + 1u == (tg + 1u) * nx) xb_add(&bar[XB_TOPGEN], 1u);
            else XB_SPIN(xb_ld(&bar[XB_TOPGEN]) == tg, bar);
            __builtin_amdgcn_fence(__ATOMIC_ACQUIRE, "agent");
            xb_add_x(&bar[XB_XGEN(b.x)], 1u);
            asm volatile("s_waitcnt vmcnt(0)" ::: "memory");
        } else {
            XB_SPIN(xb_ld_x(&bar[XB_XGEN(b.x)]) == gen, bar);
            __builtin_amdgcn_fence(__ATOMIC_ACQUIRE, "agent");
            asm volatile("s_waitcnt vmcnt(0)" ::: "memory");
        }
    }
    __syncthreads();
}
#ifndef RES_ALIGN
#define RES_ALIGN true
#endif
#ifndef UP_ALIGN
#define UP_ALIGN true
#endif
constexpr int NWAVES = 8;
constexpr int NPHASE = 13;
constexpr int CW_TMO = 0, CW_CODE = 1, CW_BAR = 4096;
static_assert((CW_BAR + XCD_BAR_WORDS) * 4 <= (int)CTL_ZERO_BYTES, "barrier words inside the memset region");
constexpr int RING_OFF = 0, RING_BYTES = 131072;
constexpr int LDSCTL_OFF = RING_BYTES, MISC_OFF = LDSCTL_OFF + 320;
constexpr int LDS_BYTES = 147456;
static_assert(MISC_OFF + 128 <= LDS_BYTES, "LDS map");

struct Frame {
    LAS unsigned char* lds;
    volatile LAS unsigned* MISC;
    gu32* ctl;
    int vcu, G, wave;
};
__device__ __forceinline__ int fresh_lane() { int l = mk_lane(); asm volatile("" : "+v"(l)); return l; }


__device__ __forceinline__ void fill_block_f4(LAS float* scr, const float* W, int ld, int k0, int n0, int lane) {
    const int c4 = 4 * (lane & 7), r0 = lane >> 3; f32x4 v[8];
#pragma unroll
    for (int j = 0; j < 8; ++j) v[j] = *(const f32x4*)(W + (size_t)(k0 + r0 + 8 * j) * ld + n0 + c4);
#pragma unroll
    for (int j = 0; j < 8; ++j) { LAS float* d = scr + (r0 + 8 * j) * 33 + c4; d[0] = v[j][0]; d[1] = v[j][1]; d[2] = v[j][2]; d[3] = v[j][3]; }
}
__device__ __forceinline__ void p0_transpose_item(const float* W, int K, int N, bf16* WT, int k0, int n0, int drow0, LAS float* scr, int lane) {
    fill_block_f4(scr, W, N, k0, n0, lane);
    LDS_WAIT(); asm volatile("" ::: "memory");
    const int c = lane & 7;
#pragma unroll
    for (int j = 0; j < 4; ++j) { const int n = (lane >> 3) + 8 * j; const LAS float* s = scr + (8 * c) * 33 + n;
        v4u o; o.x = pk2(s[0 * 33], s[1 * 33]); o.y = pk2(s[2 * 33], s[3 * 33]); o.z = pk2(s[4 * 33], s[5 * 33]); o.w = pk2(s[6 * 33], s[7 * 33]);
        *(GAS v4u*)(WT + (size_t)(drow0 + n) * K + k0 + 8 * c) = o; }
    LDS_WAIT(); asm volatile("" ::: "memory");
}
struct P0Ptrs { const float *c, *w_ada, *b_ada, *w_adaf, *b_adaf, *f1w1, *f1w3, *f1w2, *f2w1, *f2w3, *f2w2, *w_in, *w_out, *lq1, *lk1, *lq2, *lk2; unsigned char* ws; };
__device__ __forceinline__ void p0_prologue(Frame& F, const P0Ptrs& P) {
    const int f_lane = fresh_lane(), f_wave = F.wave, f_tid = f_wave * 64 + f_lane;
    LAS float* ca = (LAS float*)(F.lds + RING_OFF);
    LAS float* part = (LAS float*)(F.lds + RING_OFF + 32768);
    constexpr int NTASK_ADA = (NMOD + NMODF) / 64;
    for (int task = F.vcu; task < NTASK_ADA; task += F.G) {
        for (int i = f_tid; i < BATCH * D; i += NWAVES * 64) { const float cv = P.c[i]; ca[i] = cv / (1.0f + expf(-cv)); }
        __syncthreads();
        int j0 = task * 64; const float* W; int ld; const float* bias; float* dst; int ldd;
        if (j0 < NMOD) { W = P.w_ada + j0; ld = NMOD; bias = P.b_ada + j0; dst = (float*)(P.ws + WS_MOD) + j0; ldd = NMOD; }
        else { j0 -= NMOD; W = P.w_adaf + j0; ld = NMODF; bias = P.b_adaf + j0; dst = (float*)(P.ws + WS_MODF) + j0; ldd = NMODF; }
        float acc[BATCH];
#pragma unroll
        for (int b = 0; b < BATCH; ++b) acc[b] = 0.f;
        const int kb = f_wave * 128;
#pragma unroll 8
        for (int kk = 0; kk < 128; ++kk) { const float wv = W[(size_t)(kb + kk) * ld + f_lane];
#pragma unroll
            for (int b = 0; b < BATCH; ++b) acc[b] += ca[b * D + kb + kk] * wv; }
#pragma unroll
        for (int b = 0; b < BATCH; ++b) part[(f_wave * BATCH + b) * 64 + f_lane] = acc[b];
        __syncthreads();
        { const int b = f_tid >> 6, col = f_tid & 63; float s = 0.f;
#pragma unroll
          for (int w = 0; w < NWAVES; ++w) s += part[(w * BATCH + b) * 64 + col];
          dst[(size_t)b * ldd + col] = s + bias[col]; }
        __syncthreads();
    }
    if (blockIdx.x == gridDim.x - 1 && f_tid == 0) *(float*)(P.ws + WS_LAM) = lam_value(P.lq1, P.lk1, P.lq2, P.lk2);
    for (int e = F.vcu * (NWAVES * 64) + f_tid; e < SEQ * 32; e += F.G * NWAVES * 64) { const int t = e >> 5, dd = e & 31;
        const float inv = 1.0f / powf(10000.0f, (float)(2 * dd) / 64.0f); const float ang = (float)t * inv; float sn, cs; sincosf(ang, &sn, &cs);
        ((float*)(P.ws + WS_ROPE))[2 * e] = cs; ((float*)(P.ws + WS_ROPE))[2 * e + 1] = sn; }
    LAS float* scr = (LAS float*)(F.lds + RING_OFF + f_wave * 16384);
    const int gw = F.vcu * NWAVES + f_wave, NGW = F.G * NWAVES;
    constexpr int I_UP = (D / 64) * (FF / 32), I_DN = (FF / 64) * (D / 32), I_IN = (D / 64) * (NIN / 32), I_OUT = (D / 64) * (D / 32);
    constexpr int NITEMS = 4 * I_UP + 2 * I_DN + I_IN + I_OUT;
#ifdef P0_PIPE
    struct ItemD { const float* W; bf16* WT; int ld, K, k0, n0, drow0, cmax_idx; };
    auto decode = [&](int it, ItemD& d) { int r = it;
        if (r < 4 * I_UP) { const int which = r / I_UP; r -= which * I_UP; const int nblk = FF / 32, kbi = r / nblk, nb = r % nblk, n0 = 32 * nb;
            d.W = which == 0 ? P.f1w1 : which == 1 ? P.f1w3 : which == 2 ? P.f2w1 : P.f2w3; d.WT = nullptr; d.ld = FF; d.K = 0; d.k0 = 64 * kbi; d.n0 = n0; d.drow0 = 0;
            d.cmax_idx = CW_CMAX + (which >> 1) * 2 * FF + 256 * (n0 >> 7) + 128 * (which & 1) + (n0 & 127); return; }
        r -= 4 * I_UP; d.cmax_idx = 0;
        if (r < 2 * I_DN) { const int which = r / I_DN; r -= which * I_DN; const int nblk = D / 32, kbi = r / nblk, nb = r % nblk, n0 = 32 * nb;
            d.W = which == 0 ? P.f1w2 : P.f2w2; d.WT = (bf16*)(P.ws + (which == 0 ? WS_W2A : WS_W2B)); d.ld = D; d.K = FF; d.k0 = 64 * kbi; d.n0 = n0; d.drow0 = n0; return; }
        r -= 2 * I_DN;
        if (r < I_IN) { const int nblk = NIN / 32, kbi = r / nblk, nb = r % nblk, n0 = 32 * nb;
            int drow0 = n0; if (n0 < 1024) { const int tile = n0 >> 8, within = n0 & 255, g = within >> 6, half = (within >> 5) & 1; drow0 = tile * 256 + half * 128 + g * 32; }
            d.W = P.w_in; d.WT = (bf16*)(P.ws + WS_WIN); d.ld = NIN; d.K = D; d.k0 = 64 * kbi; d.n0 = n0; d.drow0 = drow0; return; }
        r -= I_IN;
        { const int nblk = D / 32, kbi = r / nblk, nb = r % nblk, n0 = 32 * nb; d.W = P.w_out; d.WT = (bf16*)(P.ws + WS_WOUT); d.ld = D; d.K = D; d.k0 = 64 * kbi; d.n0 = n0; d.drow0 = n0; } };
    struct Blk { f32x4 v[8]; };
    auto issue = [&](const ItemD& d, Blk& B_) { f32x4 (&v)[8] = B_.v; const int c4 = 4 * (f_lane & 7), r0 = f_lane >> 3;
#pragma unroll
        for (int j = 0; j < 8; ++j) v[j] = *(const f32x4*)(d.W + (size_t)(d.k0 + r0 + 8 * j) * d.ld + d.n0 + c4); };
    auto finish = [&](const ItemD& d, const Blk& B_) { const f32x4 (&v)[8] = B_.v; const int c4 = 4 * (f_lane & 7), r0 = f_lane >> 3;
        if (d.WT == nullptr) { float mx[4];
#pragma unroll
            for (int e = 0; e < 4; ++e) { float m = 0.f;
#pragma unroll
                for (int j = 0; j < 8; ++j) m = fmaxf(m, fabsf(v[j][e]));
                m = fmaxf(m, __shfl_xor(m, 8)); m = fmaxf(m, __shfl_xor(m, 16)); m = fmaxf(m, __shfl_xor(m, 32)); mx[e] = m; }
            if (f_lane < 8) {
#pragma unroll
                for (int e = 0; e < 4; ++e) atomicMax((unsigned*)(P.ws + WS_CTL) + d.cmax_idx + c4 + e, __float_as_uint(mx[e])); }
        } else {
#pragma unroll
            for (int j = 0; j < 8; ++j) { LAS float* q = scr + (r0 + 8 * j) * 33 + c4; q[0] = v[j][0]; q[1] = v[j][1]; q[2] = v[j][2]; q[3] = v[j][3]; }
            LDS_WAIT(); asm volatile("" ::: "memory");
            const int c = f_lane & 7;
#pragma unroll
            for (int j = 0; j < 4; ++j) { const int n = (f_lane >> 3) + 8 * j; const LAS float* sp = scr + (8 * c) * 33 + n;
                v4u o; o.x = pk2(sp[0 * 33], sp[1 * 33]); o.y = pk2(sp[2 * 33], sp[3 * 33]); o.z = pk2(sp[4 * 33], sp[5 * 33]); o.w = pk2(sp[6 * 33], sp[7 * 33]);
                *(GAS v4u*)(d.WT + (size_t)(d.drow0 + n) * d.K + d.k0 + 8 * c) = o; }
            LDS_WAIT(); asm volatile("" ::: "memory"); } };
    ItemD da, db; Blk va, vb;
    if (gw < NITEMS) { decode(gw, da); issue(da, va); }
    for (int it = gw; it < NITEMS; it += 2 * NGW) { const int it1 = it + NGW, it2 = it + 2 * NGW;
        if (it1 < NITEMS) { decode(it1, db); issue(db, vb); }
        finish(da, va);
        if (it1 < NITEMS) { if (it2 < NITEMS) { decode(it2, da); issue(da, va); } finish(db, vb); } }
#else
    for (int it = gw; it < NITEMS; it += NGW) {
        int r = it;
        if (r < 4 * I_UP) {
            const int which = r / I_UP; r -= which * I_UP; const int nblk = FF / 32, kbi = r / nblk, nb = r % nblk, n0 = 32 * nb;
            const float* W = which == 0 ? P.f1w1 : which == 1 ? P.f1w3 : which == 2 ? P.f2w1 : P.f2w3;
            const int c4 = 4 * (f_lane & 7), r0 = f_lane >> 3; f32x4 v[8];
#pragma unroll
            for (int j = 0; j < 8; ++j) v[j] = *(const f32x4*)(W + (size_t)(64 * kbi + r0 + 8 * j) * FF + n0 + c4);
            float mx[4];
#pragma unroll
            for (int e = 0; e < 4; ++e) { float m = 0.f;
#pragma unroll
                for (int j = 0; j < 8; ++j) m = fmaxf(m, fabsf(v[j][e]));
                m = fmaxf(m, __shfl_xor(m, 8)); m = fmaxf(m, __shfl_xor(m, 16)); m = fmaxf(m, __shfl_xor(m, 32)); mx[e] = m; }
            if (f_lane < 8) {
#pragma unroll
                for (int e = 0; e < 4; ++e) atomicMax((unsigned*)(P.ws + WS_CTL) + CW_CMAX + (which >> 1) * 2 * FF + 256 * (n0 >> 7) + 128 * (which & 1) + (n0 & 127) + c4 + e, __float_as_uint(mx[e])); }
            continue; }
        r -= 4 * I_UP;
        if (r < 2 * I_DN) { const int which = r / I_DN; r -= which * I_DN; const int nblk = D / 32, kbi = r / nblk, nb = r % nblk, n0 = 32 * nb;
            p0_transpose_item(which == 0 ? P.f1w2 : P.f2w2, FF, D, (bf16*)(P.ws + (which == 0 ? WS_W2A : WS_W2B)), 64 * kbi, n0, n0, scr, f_lane); continue; }
        r -= 2 * I_DN;
        if (r < I_IN) { const int nblk = NIN / 32, kbi = r / nblk, nb = r % nblk, n0 = 32 * nb;
            int drow0 = n0; if (n0 < 1024) { const int tile = n0 >> 8, within = n0 & 255, g = within >> 6, half = (within >> 5) & 1; drow0 = tile * 256 + half * 128 + g * 32; }
            p0_transpose_item(P.w_in, D, NIN, (bf16*)(P.ws + WS_WIN), 64 * kbi, n0, drow0, scr, f_lane); continue; }
        r -= I_IN;
        { const int nblk = D / 32, kbi = r / nblk, nb = r % nblk, n0 = 32 * nb; p0_transpose_item(P.w_out, D, D, (bf16*)(P.ws + WS_WOUT), 64 * kbi, n0, n0, scr, f_lane); }
    }
#endif
}
template <bool TOBF>
__device__ __forceinline__ void phase_norm(Frame& F, const float* xs, void* out, const float* g, const float* shbase, const float* scbase, int ldmod) {
    const int f_lane = fresh_lane(), f_wave = F.wave;
    const int gw = F.vcu * NWAVES + f_wave, NGW = F.G * NWAVES;
    for (int r0 = gw * 16; r0 < M; r0 += NGW * 16) { const int b = r0 / SEQ; norm_rows<TOBF>(xs, out, g, shbase + (size_t)b * ldmod, scbase + (size_t)b * ldmod, r0, 16, f_lane); }
}
__device__ __forceinline__ void phase_mix(Frame& F, const bf16* Bb, const bf16* Cb, const bf16* Ub, bf16* MIX, const float* conv_w, const float* conv_g) {
    const int f_lane = fresh_lane(), f_wave = F.wave;
    const int gw = F.vcu * NWAVES + f_wave, NGW = F.G * NWAVES;
    for (int r0 = gw * 16; r0 < M; r0 += NGW * 16) conv_rows(Bb, Cb, Ub, MIX, conv_w, conv_g, r0, 16, f_lane);
}

struct P1Ptrs { const float *f1w1, *f1w3, *f2w1, *f2w3; };
template <int NW_ = NWAVES>
__device__ __forceinline__ void phase_p1_extras(Frame& F, unsigned char* ws, const float* mod, const P1Ptrs& P, int wv) {
    const int f_lane = fresh_lane(), f_wave = F.wave;
    const int gw = F.vcu * NW_ + wv, NGW = F.G * NW_;
    for (int i = gw * 64 + f_lane; i < 3 * M; i += NGW * 64) ((float*)(ws + WS_RSS2))[i] = 0.f;
    constexpr int NT_IN = NIN / 4;
    for (int task = gw; task < NT_IN; task += NGW) {
        const int n0 = 4 * task;
        const bf16* Wt = (const bf16*)(ws + WS_WIN) + (size_t)n0 * D;
        const float* sh = mod + 3 * D;
        float* dst = (float*)(ws + WS_SHWIN) + n0; const int ldd = NIN;
        float w[4][16];
#pragma unroll
        for (int r = 0; r < 4; ++r)
#pragma unroll
            for (int j = 0; j < 2; ++j) { float f[8]; unpack8(*(const v4u*)(Wt + (size_t)r * D + 512 * j + 8 * f_lane), f);
#pragma unroll
                for (int e = 0; e < 8; ++e) w[r][8 * j + e] = f[e]; }
#pragma unroll 1
        for (int b = 0; b < BATCH; ++b) {
            float sv[16];
#pragma unroll
            for (int j = 0; j < 2; ++j) { const f32x4 a = *(const f32x4*)(sh + (size_t)b * NMOD + 512 * j + 8 * f_lane), c = *(const f32x4*)(sh + (size_t)b * NMOD + 512 * j + 8 * f_lane + 4);
                sv[8 * j + 0] = a.x; sv[8 * j + 1] = a.y; sv[8 * j + 2] = a.z; sv[8 * j + 3] = a.w; sv[8 * j + 4] = c.x; sv[8 * j + 5] = c.y; sv[8 * j + 6] = c.z; sv[8 * j + 7] = c.w; }
#pragma unroll
            for (int r = 0; r < 4; ++r) { float d = 0.f;
#pragma unroll
                for (int e = 0; e < 16; ++e) d += w[r][e] * sv[e];
                d = wave_sum(d); if (f_lane == 0) dst[(size_t)b * ldd + r] = d; }
        }
    }
    LAS float* scr = (LAS float*)(F.lds + RING_OFF + f_wave * 16384);
    constexpr int I_UP = (D / 64) * (FF / 32), NIT = 4 * I_UP;
    struct QItem { f32x4 v[8]; float cmax; };
    auto q_issue = [&](QItem& Q, int it) {
        const int which = it / I_UP, r = it - which * I_UP; const int nblk = FF / 32, kbi = r / nblk, nb = r % nblk, n0 = 32 * nb, k0 = 64 * kbi;
        const float* W = which == 0 ? P.f1w1 : which == 1 ? P.f1w3 : which == 2 ? P.f2w1 : P.f2w3;
        const int drow0 = 256 * (n0 >> 7) + 128 * (which & 1) + (n0 & 127);
        const int c4 = 4 * (f_lane & 7), r0 = f_lane >> 3;
#pragma unroll
        for (int j = 0; j < 8; ++j) Q.v[j] = *(const f32x4*)(W + (size_t)(k0 + r0 + 8 * j) * FF + n0 + c4);
        Q.cmax = __uint_as_float(atomicMax((unsigned*)(ws + WS_CTL) + CW_CMAX + (which >> 1) * 2 * FF + drow0 + (f_lane >> 1), 0u));
    };
    auto q_finish = [&](const QItem& Q, int it) {
        const int which = it / I_UP, r = it - which * I_UP; const int nblk = FF / 32, kbi = r / nblk, nb = r % nblk, n0 = 32 * nb, k0 = 64 * kbi;
        const int drow0 = 256 * (n0 >> 7) + 128 * (which & 1) + (n0 & 127);
        const int n = f_lane >> 1, half = f_lane & 1, c4 = 4 * (f_lane & 7), r0 = f_lane >> 3;
#pragma unroll
        for (int j = 0; j < 8; ++j) { LAS float* d = scr + (r0 + 8 * j) * 33 + c4; d[0] = Q.v[j][0]; d[1] = Q.v[j][1]; d[2] = Q.v[j][2]; d[3] = Q.v[j][3]; }
        LDS_WAIT(); asm volatile("" ::: "memory");
        const float cmax = Q.cmax, cscale = cmax > 0.f ? cmax * (1.0f / 127.0f) : 1.0f, inv = 1.0f / cscale;
        const LAS float* sp = scr + (32 * half) * 33 + n;
        v4u o0, o1;
        o0.x = q8pack(sp[0 * 33], sp[1 * 33], sp[2 * 33], sp[3 * 33], inv);     o0.y = q8pack(sp[4 * 33], sp[5 * 33], sp[6 * 33], sp[7 * 33], inv);
        o0.z = q8pack(sp[8 * 33], sp[9 * 33], sp[10 * 33], sp[11 * 33], inv);   o0.w = q8pack(sp[12 * 33], sp[13 * 33], sp[14 * 33], sp[15 * 33], inv);
        o1.x = q8pack(sp[16 * 33], sp[17 * 33], sp[18 * 33], sp[19 * 33], inv); o1.y = q8pack(sp[20 * 33], sp[21 * 33], sp[22 * 33], sp[23 * 33], inv);
        o1.z = q8pack(sp[24 * 33], sp[25 * 33], sp[26 * 33], sp[27 * 33], inv); o1.w = q8pack(sp[28 * 33], sp[29 * 33], sp[30 * 33], sp[31 * 33], inv);
        signed char* W8 = (signed char*)(ws + (which < 2 ? WS_W13A : WS_W13B)) + (size_t)(drow0 + n) * D + k0 + 32 * half;
        *(GAS v4u*)W8 = o0; *(GAS v4u*)(W8 + 16) = o1;
        if (kbi == 0 && half == 0) ((float*)(ws + WS_CS))[(which >> 1) * 2 * FF + drow0 + n] = cscale;
        LDS_WAIT(); asm volatile("" ::: "memory");
    };
    QItem qa, qb;
    if (gw < NIT) q_issue(qa, gw);
    for (int it = gw; it < NIT; it += 2 * NGW) {
        const int it1 = it + NGW, it2 = it + 2 * NGW;
        if (it1 < NIT) q_issue(qb, it1);
        q_finish(qa, it);
        if (it1 < NIT) { if (it2 < NIT) q_issue(qa, it2); q_finish(qb, it1); }
    }
}
template <int NW_ = NWAVES>
__device__ __forceinline__ void phase_norm_q8(Frame& F, const float* xs, signed char* H8, float* rs, const float* g, const float* shbase, const float* scbase, int wv) {
    const int f_lane = fresh_lane();
    constexpr int RPW = 16 * NWAVES / NW_;
    const int gw = F.vcu * NW_ + wv, NGW = F.G * NW_;
    for (int r0 = gw * RPW; r0 < M; r0 += NGW * RPW) { const int b = r0 / SEQ; norm_rows_q8(xs, H8, rs, g, shbase + (size_t)b * NMOD, scbase + (size_t)b * NMOD, r0, RPW, f_lane); }
}
__device__ __forceinline__ void phase_norm_q8_bf(Frame& F, const bf16* xs, const float* rss, signed char* H8, float* rs, const float* g, const float* shbase, const float* scbase) {
    const int f_lane = fresh_lane(), f_wave = F.wave;
    const int gw = F.vcu * NWAVES + f_wave, NGW = F.G * NWAVES;
    for (int r0 = gw * 16; r0 < M; r0 += NGW * 16) { const int b = r0 / SEQ; norm_rows_q8_bf(xs, rss, H8, rs, g, shbase + (size_t)b * NMOD, scbase + (size_t)b * NMOD, r0, 16, f_lane); }
}
__device__ __forceinline__ void phase_final(Frame& F, const bf16* xs, const float* rss, float* out, const float* g, const float* shbase, const float* scbase) {
    const int f_lane = fresh_lane(), f_wave = F.wave;
    const int gw = F.vcu * NWAVES + f_wave, NGW = F.G * NWAVES;
    for (int r0 = gw * 16; r0 < M; r0 += NGW * 16) { const int b = r0 / SEQ;
        f32x4 gm[4], sh[4];
#pragma unroll
        for (int j = 0; j < 4; ++j) { const int c = 256 * j + 4 * f_lane; gm[j] = *(const f32x4*)(g + c) * (*(const f32x4*)(scbase + (size_t)b * NMODF + c) + 1.0f); sh[j] = *(const f32x4*)(shbase + (size_t)b * NMODF + c); }
        v2u q[4], n[4]; float ssq = rss[r0], nss = 0.f;
#pragma unroll
        for (int j = 0; j < 4; ++j) q[j] = *(const v2u*)(xs + (size_t)r0 * D + 256 * j + 4 * f_lane);
        for (int r = r0; r < r0 + 16; ++r) {
            if (r + 1 < r0 + 16) { nss = rss[r + 1];
#pragma unroll
                for (int j = 0; j < 4; ++j) n[j] = *(const v2u*)(xs + (size_t)(r + 1) * D + 256 * j + 4 * f_lane); }
            const float rs = pg8::rs_of(ssq);
#pragma unroll
            for (int j = 0; j < 4; ++j) { const f32x4 v = (f32x4){bf2f(q[j].x & 0xffffu), bf2f(q[j].x >> 16), bf2f(q[j].y & 0xffffu), bf2f(q[j].y >> 16)};
                *(f32x4*)(out + (size_t)r * D + 256 * j + 4 * f_lane) = v * rs * gm[j] + sh[j]; }
#pragma unroll
            for (int j = 0; j < 4; ++j) q[j] = n[j];
            ssq = nss; }
    }
}

__device__ __forceinline__ bool phase_in(int k) { const pg8::kargs_ptr ka = pg8::kargs_fresh(); return ka->ph_lo <= k && k < ka->ph_hi; }
__device__ __forceinline__ bool phase_after(int k) { const pg8::kargs_ptr ka = pg8::kargs_fresh(); return ka->ph_lo <= k && k + 1 < ka->ph_hi; }
__global__ void __launch_bounds__(NWAVES * 64, 2) skel_fwd(Args args) {
    extern __shared__ __attribute__((aligned(16))) unsigned char lds[];
    Frame F;
    F.lds = (LAS unsigned char*)lds;
    F.MISC = (volatile LAS unsigned*)(F.lds + MISC_OFF);
    F.wave = __builtin_amdgcn_readfirstlane((int)threadIdx.x >> 6);
    F.G = gridDim.x; { const int bx = blockIdx.x; F.vcu = (F.G % 8 == 0) ? (bx % 8) * (F.G / 8) + bx / 8 : bx; }
    unsigned char* ws = args.ws;
    F.ctl = (gu32*)(ws + WS_CTL);
    for (int u = threadIdx.x; u < (LDS_BYTES - LDSCTL_OFF) / 4; u += NWAVES * 64) ((LAS unsigned*)(F.lds + LDSCTL_OFF))[u] = 0u;
    __syncthreads();
    XcdBarrier bar; bar.bar = (unsigned*)(F.ctl + CW_BAR); bar.x = 0; bar.st = nullptr; bar.wave = F.wave;
    if (args.use_bar) { bar = xcd_barrier_post((unsigned*)(F.ctl + CW_BAR), F.MISC + 8); bar.wave = F.wave; }
#ifndef BAR_REP
#define BAR_REP 1
#endif
#define GRID_BAR() do { if (args.use_bar) { for (int _r = 0; _r < BAR_REP; ++_r) xcd_barrier(bar); } } while (0)
#define IN(k) phase_in(k)
#define AFTER(k) do { if (phase_after(k)) GRID_BAR(); } while (0)
#ifdef BAR_LOCAL_SKIP
#define AFTERL(k) do { if (phase_after(k)) { if (args.use_bar) xcd_barrier<true>(bar); } } while (0)
#else
#define AFTERL(k) AFTER(k)
#endif
    if (IN(0)) { unsigned char* ws = pg8::kargs_fresh()->ws; const pg8::kargs_ptr ka = pg8::kargs_fresh();
            P0Ptrs P{ka->in[1], ka->in[2], ka->in[3], ka->in[4], ka->in[5], ka->in[10], ka->in[11], ka->in[12], ka->in[13], ka->in[14], ka->in[15], ka->in[16], ka->in[24], ka->in[17], ka->in[18], ka->in[19], ka->in[20], ws};
            p0_prologue(F, P); AFTER(0); }
    if (IN(1)) { unsigned char* ws = pg8::kargs_fresh()->ws; const pg8::kargs_ptr ka = pg8::kargs_fresh(); const float* mod = (const float*)(ws + WS_MOD);
#ifdef P1_SERIAL
            { P1Ptrs P1{ka->in[10], ka->in[11], ka->in[13], ka->in[14]}; phase_p1_extras<NWAVES>(F, ws, mod, P1, F.wave); }
            phase_norm_q8<NWAVES>(F, ka->in[0], (signed char*)(ws + WS_H), (float*)(ws + WS_RS1), ka->in[6], mod + 0 * D, mod + 1 * D, F.wave);
#else
            if (F.wave < 4) phase_norm_q8<4>(F, ka->in[0], (signed char*)(ws + WS_H), (float*)(ws + WS_RS1), ka->in[6], mod + 0 * D, mod + 1 * D, F.wave);
#ifdef P1_PRIO
            else { __builtin_amdgcn_s_setprio(1); P1Ptrs P1{ka->in[10], ka->in[11], ka->in[13], ka->in[14]}; phase_p1_extras<4>(F, ws, mod, P1, F.wave - 4); __builtin_amdgcn_s_setprio(0); }
#else
            else { P1Ptrs P1{ka->in[10], ka->in[11], ka->in[13], ka->in[14]}; phase_p1_extras<4>(F, ws, mod, P1, F.wave - 4); }
#endif
#endif
            AFTER(1); }
    if (IN(2)) { unsigned char* ws = pg8::kargs_fresh()->ws; pg8::Gemm g{(const bf16*)(ws + WS_H), (const bf16*)(ws + WS_W13A), M, 2 * FF, D / 2}; pg8::StaticOrder S; S.init(M, 2 * FF, F.G, (int)blockIdx.x); pg8::EpiSwiGLUq<0> E{};

            pg8::gemm_phase<pg8::EpiSwiGLUq<0>, pg8::StaticOrder, UP_ALIGN, true>(F.lds + RING_OFF, g, S, E, F.wave);
            AFTERL(2); }
    if (IN(3)) { unsigned char* ws = pg8::kargs_fresh()->ws; pg8::Gemm g{(const bf16*)(ws + WS_G), (const bf16*)(ws + WS_W2A), M, D, FF}; pg8::StaticOrder S; S.init(M, D, F.G, (int)blockIdx.x); pg8::EpiResidN<0> E{};
            pg8::gemm_phase<pg8::EpiResidN<0>, pg8::StaticOrder, RES_ALIGN, true>(F.lds + RING_OFF, g, S, E, F.wave); AFTER(3); }
    if (IN(5)) { unsigned char* ws = pg8::kargs_fresh()->ws; pg8::Gemm g{(const bf16*)(ws + WS_H), (const bf16*)(ws + WS_WIN), M, NIN, D}; pg8::StaticOrder S; S.init(M, NIN, F.G, (int)blockIdx.x); pg8::EpiZ E{};
            pg8::gemm_phase<pg8::EpiZ, pg8::StaticOrder, true, true>(F.lds + RING_OFF, g, S, E, F.wave); AFTERL(5); }
    if (IN(6)) { unsigned char* ws = pg8::kargs_fresh()->ws; const pg8::kargs_ptr ka = pg8::kargs_fresh(); const attn128::AttnTensors AT{(const bf16*)(ws + WS_Q), (const bf16*)(ws + WS_K), (const bf16*)(ws + WS_V), (bf16*)(ws + WS_AO), (bf16*)(ws + WS_MIX), ka->in[21], (const float*)(ws + WS_LAM), {(const bf16*)(ws + WS_B), (const bf16*)(ws + WS_C), (const bf16*)(ws + WS_U), ka->in[22], ka->in[23]}}; const attn128::StaticOrder S((int)F.G, (int)blockIdx.x);
            attn128::attn_phase<attn128::StaticOrder>((char*)lds + RING_OFF, AT, S, F.wave); AFTER(6); }
    if (IN(8)) { unsigned char* ws = pg8::kargs_fresh()->ws; pg8::Gemm g{(const bf16*)(ws + WS_MIX), (const bf16*)(ws + WS_WOUT), M, D, D}; pg8::StaticOrder S; S.init(M, D, F.G, (int)blockIdx.x); pg8::EpiResidN<1> E{};
            pg8::gemm_phase<pg8::EpiResidN<1>, pg8::StaticOrder, RES_ALIGN, true>(F.lds + RING_OFF, g, S, E, F.wave); AFTERL(8); }
    if (IN(9)) { unsigned char* ws = pg8::kargs_fresh()->ws; const pg8::kargs_ptr ka = pg8::kargs_fresh(); const float* mod = (const float*)(ws + WS_MOD);
            phase_norm_q8_bf(F, (const bf16*)(ws + WS_XS2), (const float*)(ws + WS_RSS3), (signed char*)(ws + WS_H), (float*)(ws + WS_RS3), ka->in[8], mod + 6 * D, mod + 7 * D); AFTERL(9); }
    if (IN(10)) { unsigned char* ws = pg8::kargs_fresh()->ws; pg8::Gemm g{(const bf16*)(ws + WS_H), (const bf16*)(ws + WS_W13B), M, 2 * FF, D / 2}; pg8::StaticOrder S; S.init(M, 2 * FF, F.G, (int)blockIdx.x); pg8::EpiSwiGLUq<1> E{};

            pg8::gemm_phase<pg8::EpiSwiGLUq<1>, pg8::StaticOrder, UP_ALIGN, true>(F.lds + RING_OFF, g, S, E, F.wave);
            AFTERL(10); }
    if (IN(11)) { unsigned char* ws = pg8::kargs_fresh()->ws; pg8::Gemm g{(const bf16*)(ws + WS_G), (const bf16*)(ws + WS_W2B), M, D, FF}; pg8::StaticOrder S; S.init(M, D, F.G, (int)blockIdx.x); pg8::EpiResidN<2> E{};
            pg8::gemm_phase<pg8::EpiResidN<2>, pg8::StaticOrder, RES_ALIGN, true>(F.lds + RING_OFF, g, S, E, F.wave); AFTERL(11); }
    if (IN(12)) { unsigned char* ws = pg8::kargs_fresh()->ws; const pg8::kargs_ptr ka = pg8::kargs_fresh(); const float* modf = (const float*)(ws + WS_MODF);
            phase_final(F, (const bf16*)(ws + WS_XS1), (const float*)(ws + WS_RSS4), ka->out, ka->in[9], modf + 0, modf + D); }
#undef IN
#undef AFTER
#undef AFTERL
#undef GRID_BAR
}
#ifndef MK_MODE
#define MK_MODE 1
#endif
#ifndef NAIVE_MASK
#define NAIVE_MASK 0
#endif
#ifndef PROBE_REP
#define PROBE_REP 1
#endif
#ifndef REPEAT_MASK
#define REPEAT_MASK 0
#endif
extern "C" void kernel_launch(void* const* d_in, const int* in_sizes, int n_in, void* d_out, int out_size, void* d_ws, size_t ws_size, hipStream_t stream) {
    static int grid = 0;
    if (grid == 0) {
        if (n_in != 25 || in_sizes[0] != M * D || out_size != M * D || ws_size < WS_END) { fprintf(stderr, "kernel_launch: unexpected shapes (n_in %d, in0 %d, out %d, ws %zu)\n", n_in, n_in > 0 ? in_sizes[0] : -1, out_size, ws_size); grid = -1; return; }
        int dev = 0, cus = 0, per_cu = 0;
        if (hipGetDevice(&dev) != hipSuccess || hipDeviceGetAttribute(&cus, hipDeviceAttributeMultiprocessorCount, dev) != hipSuccess) { grid = -1; return; }
        if (hipFuncSetAttribute((const void*)skel_fwd, hipFuncAttributeMaxDynamicSharedMemorySize, LDS_BYTES) != hipSuccess) { fprintf(stderr, "kernel_launch: hipFuncSetAttribute failed\n"); grid = -1; return; }
        if (hipOccupancyMaxActiveBlocksPerMultiprocessor(&per_cu, (const void*)skel_fwd, NWAVES * 64, LDS_BYTES) != hipSuccess || per_cu < 1) { fprintf(stderr, "kernel_launch: occupancy query says %d blocks per CU\n", per_cu); per_cu = 1; }
        (void)hipGetLastError();
        grid = cus;
        fprintf(stderr, "kernel_launch: grid %d (occupancy query %d per CU), ws %zu\n", grid, per_cu, ws_size);
    }
    if (grid < 0) return;
    (void)hipMemsetAsync((char*)d_ws + WS_CTL, 0, CTL_ZERO_BYTES, stream);
    Args a{};
    for (int i = 0; i < 25; ++i) a.in[i] = (const float*)d_in[i];
    a.out = (float*)d_out; a.ws = (unsigned char*)d_ws;
#if MK_MODE == 1
    a.ph_lo = 0; a.ph_hi = NPHASE; a.use_bar = 1;
    hipLaunchKernelGGL(skel_fwd, dim3(grid), dim3(NWAVES * 64), LDS_BYTES, stream, a);
#else
    for (int k = 0; k < NPHASE; ++k) { a.ph_lo = k; a.ph_hi = k + 1; a.use_bar = 0;
        for (int rr = 0; rr <= ((REPEAT_MASK >> k) & 1); ++rr) hipLaunchKernelGGL(skel_fwd, dim3(grid), dim3(NWAVES * 64), LDS_BYTES, stream, a);
#if defined(PROBE_ID) && defined(PROBE_AFTER)
        if (k == PROBE_AFTER) { static bool once2 = false; if (!once2) { once2 = true; (void)hipFuncSetAttribute((const void*)probe_fwd, hipFuncAttributeMaxDynamicSharedMemorySize, LDS_BYTES); }
            for (int rr = 0; rr < PROBE_REP; ++rr) hipLaunchKernelGGL(probe_fwd, dim3(grid), dim3(NWAVES * 64), LDS_BYTES, stream, a); }
#endif
    }
#if defined(PROBE_ID) && !defined(PROBE_AFTER)
#ifdef PROBE_ZERO
    (void)hipMemsetAsync((char*)d_ws + WS_H, 0, (size_t)M * D * 2, stream); (void)hipMemsetAsync((char*)d_ws + WS_W13B, 0, (size_t)2 * FF * D * 2, stream);
#endif
    { static bool once = false; if (!once) { once = true; (void)hipFuncSetAttribute((const void*)probe_fwd, hipFuncAttributeMaxDynamicSharedMemorySize, LDS_BYTES); }
      for (int rr = 0; rr < PROBE_REP; ++rr) hipLaunchKernelGGL(probe_fwd, dim3(grid), dim3(NWAVES * 64), LDS_BYTES, stream, a); }
#endif
#endif
}
```
